# Optimizing an MI355X kernel written in HIP

```python
import math
import jax
import jax.numpy as jnp
from jax import lax
import numpy as np

D_MODEL = 1024
BATCH = 16
SEQ = 256
DEPTH = 4
DEC_BATCH = 2
DEC_SEQ = 4096
PAST_LEN = 256

GRID_W = 64
MIX_W = D_MODEL
GROUP_W = MIX_W // 4
H_A = 4
DV_A = GROUP_W // H_A
DQK_A = DV_A // 2
H_B = 4
DK_B = GROUP_W // H_B
DV_B = GROUP_W // H_B
H_C = 4
NOPE_C = 64
ROPE_C = 32
V_C = GROUP_W // H_C
Q_RANK = 256
KV_RANK = 128
H_D = 4
P_D = GROUP_W // H_D
N_D = 128
G_D = 2
CONV_W = 3
CHUNK = 64
Q_BLOCK = 128
D_FF = 4 * D_MODEL
ROPE_BASE = 10000.0
EPS = 1e-6
ALPHA = (2 * DEPTH) ** 0.25
BETA_INIT = (8 * DEPTH) ** -0.25
SPLIT_SIZES = (
    H_A * 2 * DQK_A, H_A * 2 * DQK_A, H_A * DV_A,
    H_B * (2 * DK_B + DV_B), 2 * H_B, 2 * H_B, H_B * DV_B,
    Q_RANK, KV_RANK, ROPE_C,
    H_D * P_D, H_D * P_D + 2 * G_D * N_D, 2 * H_D,
)
IN_COLS = sum(SPLIT_SIZES)

kernel_name = 'hybrid_diffusion_parallel_heads_step'


def rms_norm(x, g):
    xf = x.astype(jnp.float32)
    y = xf * lax.rsqrt(jnp.mean(xf * xf, axis=-1, keepdims=True) + EPS)
    return y * g.astype(jnp.float32)


def layer_norm(x, g, b):
    xf = x.astype(jnp.float32)
    mu = jnp.mean(xf, axis=-1, keepdims=True)
    var = jnp.mean(jnp.square(xf - mu), axis=-1, keepdims=True)
    y = (xf - mu) * lax.rsqrt(var + EPS) * g.astype(jnp.float32) + b.astype(jnp.float32)
    return y.astype(x.dtype)


def l2_normalize(x):
    xf = x.astype(jnp.float32)
    return xf * lax.rsqrt(jnp.sum(xf * xf, axis=-1, keepdims=True) + EPS)


def depthwise_conv(x, w, b=None):
    pad = CONV_W // 2
    y = lax.conv_general_dilated(x, w[:, None, :].astype(x.dtype), window_strides=(1,),
                                 padding=[(pad, pad)], dimension_numbers=('NWC', 'WIO', 'NWC'),
                                 feature_group_count=x.shape[-1])
    return y if b is None else y + b.astype(x.dtype)


def rope2d_tables(length, dim):
    rows = length // GRID_W
    row_pos = jnp.repeat(jnp.arange(rows, dtype=jnp.float32), GRID_W)
    col_pos = jnp.tile(jnp.arange(GRID_W, dtype=jnp.float32), rows)
    half = dim // 2
    inv_freq = ROPE_BASE ** (-jnp.arange(0, half, 2, dtype=jnp.float32) / half)
    ang_r = row_pos[:, None] * inv_freq
    ang_c = col_pos[:, None] * inv_freq
    ang = jnp.concatenate([ang_r, ang_r, ang_c, ang_c], axis=-1)
    return jnp.cos(ang), jnp.sin(ang)


def apply_rope2d(x, cos, sin):
    qd = x.shape[-1] // 4
    x1, x2, x3, x4 = (x[..., i * qd:(i + 1) * qd] for i in range(4))
    rot = jnp.concatenate([-x2, x1, -x4, x3], axis=-1)
    shape = (1, x.shape[1]) + (1,) * (x.ndim - 3) + (x.shape[-1],)
    return x * cos.reshape(shape).astype(x.dtype) + rot * sin.reshape(shape).astype(x.dtype)


def over_query_blocks(fn, q):
    b, lq = q.shape[:2]
    nb = lq // Q_BLOCK
    blocks = jnp.moveaxis(q.reshape(b, nb, Q_BLOCK, *q.shape[2:]), 1, 0)
    out = jnp.moveaxis(lax.map(fn, blocks), 0, 1)
    return out.reshape(b, lq, *out.shape[3:])


def diff_attention(q, k, v, lam):
    scale = DQK_A ** -0.5

    def block(qb):
        s = jnp.einsum('bqhtd,bkhtd->bhtqk', qb, k).astype(jnp.float32) * scale
        p = jax.nn.softmax(s, axis=-1)
        w = p[:, :, 0] - lam * p[:, :, 1]
        return jnp.einsum('bhqk,bkhv->bqhv', w.astype(v.dtype), v)

    return over_query_blocks(block, q)


def softmax_attention(q, k, v):
    scale = q.shape[-1] ** -0.5

    def block(qb):
        s = jnp.einsum('bqhd,bkhd->bhqk', qb, k).astype(jnp.float32) * scale
        p = jax.nn.softmax(s, axis=-1)
        return jnp.einsum('bhqk,bkhv->bqhv', p.astype(v.dtype), v)

    return over_query_blocks(block, q)


def to_chunks(t):
    b, l, h = t.shape[:3]
    t = t.reshape(b, l // CHUNK, CHUNK, h, *t.shape[3:])
    return jnp.moveaxis(t, 3, 2)


def from_chunks(t):
    t = jnp.moveaxis(t, 2, 3)
    return t.reshape(t.shape[0], t.shape[1] * t.shape[2], t.shape[3], t.shape[4])


def gated_delta_chunked(q, k, v, beta, g, s0):
    qc, kc, vc, bc = to_chunks(q), to_chunks(k), to_chunks(v), to_chunks(beta)
    gc = jnp.cumsum(to_chunks(g), axis=-1)
    idx = jnp.arange(CHUNK)
    causal = idx[:, None] >= idx[None, :]
    strict = idx[:, None] > idx[None, :]
    decay = jnp.exp(jnp.where(causal, gc[..., :, None] - gc[..., None, :], -jnp.inf))
    kb = kc * bc[..., None]
    a_mat = jnp.where(strict, jnp.einsum('bchid,bchjd->bchij', kb, kc) * decay, 0.0)
    eye = jnp.eye(CHUNK, dtype=jnp.float32)
    t_mat = lax.linalg.triangular_solve(eye + a_mat, jnp.broadcast_to(eye, a_mat.shape),
                                        left_side=True, lower=True, unit_diagonal=True)
    u = t_mat @ (vc * bc[..., None])
    w = t_mat @ (kb * jnp.exp(gc)[..., None])
    qk = jnp.where(causal, jnp.einsum('bchid,bchjd->bchij', qc, kc) * decay, 0.0)
    q_dec = qc * jnp.exp(gc)[..., None]
    k_dec = kc * jnp.exp(gc[..., -1:] - gc)[..., None]
    g_last = gc[..., -1]

    def step(s, inp):
        q_i, k_i, u_i, w_i, qk_i, gl_i = inp
        v_new = u_i - w_i @ s
        o = q_i @ s + qk_i @ v_new
        s = s * jnp.exp(gl_i)[..., None, None] + jnp.einsum('bhck,bhcv->bhkv', k_i, v_new)
        return s, o

    xs = tuple(jnp.moveaxis(t, 1, 0) for t in (q_dec, k_dec, u, w, qk, g_last))
    s_fin, o = lax.scan(step, s0, xs)
    return from_chunks(jnp.moveaxis(o, 0, 1)), s_fin


def ssd_chunked(x, dt, a, bm, cm, s0):
    rep = x.shape[2] // bm.shape[2]
    bc = to_chunks(jnp.repeat(bm, rep, axis=2))
    cc = to_chunks(jnp.repeat(cm, rep, axis=2))
    xdt = to_chunks(x * dt[..., None])
    ac = jnp.cumsum(to_chunks(dt * a), axis=-1)
    idx = jnp.arange(CHUNK)
    causal = idx[:, None] >= idx[None, :]
    seg = jnp.exp(jnp.where(causal, ac[..., :, None] - ac[..., None, :], -jnp.inf))
    y_intra = jnp.einsum('bchij,bchjp->bchip', jnp.einsum('bchis,bchjs->bchij', cc, bc) * seg, xdt)
    last = ac[..., -1]
    states = jnp.einsum('bchjs,bchjp->bchps', bc * jnp.exp(last[..., None] - ac)[..., None], xdt)
    c_dec = cc * jnp.exp(ac)[..., None]

    def step(s, inp):
        c_i, st_i, last_i = inp
        y = jnp.einsum('bhis,bhps->bhip', c_i, s)
        s = s * jnp.exp(last_i)[..., None, None] + st_i
        return s, y

    xs = tuple(jnp.moveaxis(t, 1, 0) for t in (c_dec, states, last))
    s_fin, y_inter = lax.scan(step, s0, xs)
    return from_chunks(y_intra + jnp.moveaxis(y_inter, 0, 1)), s_fin


def mixer_diff(q, k, v, lam_p, norm_g, layer, rope, past_k, past_v):
    b, l = q.shape[:2]
    q = q.reshape(b, l, H_A, 2, DQK_A)
    k = k.reshape(b, l, H_A, 2, DQK_A)
    v = v.reshape(b, l, H_A, DV_A)
    own_k, own_v = k, v
    if rope is not None:
        q = apply_rope2d(q, *rope)
        k = apply_rope2d(k, *rope)
    if past_k is not None:
        k = jnp.concatenate([k, past_k.astype(k.dtype)], axis=1)
        v = jnp.concatenate([v, past_v.astype(v.dtype)], axis=1)
    lam_init = 0.8 - 0.6 * math.exp(-0.3 * layer)
    lp = lam_p.astype(jnp.float32)
    lam = jnp.exp(jnp.sum(lp[0] * lp[1])) - jnp.exp(jnp.sum(lp[2] * lp[3])) + lam_init
    o = diff_attention(q, k, v, lam)
    o = rms_norm(o, norm_g) * (1.0 - lam_init)
    return o.reshape(b, l, GROUP_W).astype(q.dtype), own_k, own_v


def mixer_deltanet(qkv, beta_raw, decay_raw, gate, conv_w, a_log, dt_bias, norm_g, past_state):
    b, l = qkv.shape[:2]
    qkv = jax.nn.silu(depthwise_conv(qkv, conv_w))
    q, k, v = jnp.split(qkv, [H_B * DK_B, 2 * H_B * DK_B], axis=-1)
    q = l2_normalize(q.reshape(b, l, H_B, DK_B)) * DK_B ** -0.5
    k = l2_normalize(k.reshape(b, l, H_B, DK_B))
    v = v.reshape(b, l, H_B, DV_B).astype(jnp.float32)
    beta = jax.nn.sigmoid(beta_raw.astype(jnp.float32)).reshape(b, l, 2, H_B)
    g = -jnp.exp(a_log.astype(jnp.float32)) * jax.nn.softplus(
        decay_raw.astype(jnp.float32).reshape(b, l, 2, H_B) + dt_bias.astype(jnp.float32))
    if past_state is None:
        s0 = jnp.zeros((b, 2, H_B, DK_B, DV_B), jnp.float32)
    else:
        s0 = past_state.astype(jnp.float32)
    fl = lambda t: jnp.flip(t, axis=1)
    o_f, s_f = gated_delta_chunked(q, k, v, beta[:, :, 0], g[:, :, 0], s0[:, 0])
    o_b, s_b = gated_delta_chunked(fl(q), fl(k), fl(v), fl(beta[:, :, 1]), fl(g[:, :, 1]), s0[:, 1])
    o = rms_norm(o_f + fl(o_b), norm_g) * jax.nn.silu(gate.reshape(b, l, H_B, DV_B).astype(jnp.float32))
    return o.reshape(b, l, GROUP_W).astype(qkv.dtype), jnp.stack([s_f, s_b], axis=1)


def mixer_mla(c_q, c_kv, k_rope, q_norm, kv_norm, w_uq, w_uk, w_uv, rope, past_ckv, past_kr):
    b, l = c_q.shape[:2]
    q = (rms_norm(c_q, q_norm).astype(c_q.dtype) @ w_uq).reshape(b, l, H_C, NOPE_C + ROPE_C)
    q_nope, q_rope = q[..., :NOPE_C], q[..., NOPE_C:]
    ckv = rms_norm(c_kv, kv_norm).astype(c_kv.dtype)
    own_ckv, own_kr = ckv, k_rope
    if rope is not None:
        q_rope = apply_rope2d(q_rope, *rope)
        k_rope = apply_rope2d(k_rope, *rope)
    if past_ckv is not None:
        ckv = jnp.concatenate([ckv, past_ckv.astype(ckv.dtype)], axis=1)
        k_rope = jnp.concatenate([k_rope, past_kr.astype(k_rope.dtype)], axis=1)
    lk = ckv.shape[1]
    k_nope = (ckv @ w_uk).reshape(b, lk, H_C, NOPE_C)
    v = (ckv @ w_uv).reshape(b, lk, H_C, V_C)
    k = jnp.concatenate([k_nope, jnp.broadcast_to(k_rope[:, :, None, :], (b, lk, H_C, ROPE_C))], axis=-1)
    q = jnp.concatenate([q_nope, q_rope], axis=-1)
    o = softmax_attention(q, k, v)
    return o.reshape(b, l, GROUP_W), own_ckv, own_kr


def mixer_ssd(z, xbc, dt_raw, conv_w, conv_b, a_log, dt_bias, d_skip, norm_g, past_state):
    b, l = z.shape[:2]
    xbc = jax.nn.silu(depthwise_conv(xbc, conv_w, conv_b))
    x, bm, cm = jnp.split(xbc, [H_D * P_D, H_D * P_D + G_D * N_D], axis=-1)
    x = x.reshape(b, l, H_D, P_D).astype(jnp.float32)
    bm = bm.reshape(b, l, G_D, N_D).astype(jnp.float32)
    cm = cm.reshape(b, l, G_D, N_D).astype(jnp.float32)
    dt = jax.nn.softplus(dt_raw.astype(jnp.float32).reshape(b, l, 2, H_D) + dt_bias.astype(jnp.float32))
    a = -jnp.exp(a_log.astype(jnp.float32))
    if past_state is None:
        s0 = jnp.zeros((b, 2, H_D, P_D, N_D), jnp.float32)
    else:
        s0 = past_state.astype(jnp.float32)
    fl = lambda t: jnp.flip(t, axis=1)
    y_f, s_f = ssd_chunked(x, dt[:, :, 0], a[0], bm, cm, s0[:, 0])
    y_b, s_b = ssd_chunked(fl(x), fl(dt[:, :, 1]), a[1], fl(bm), fl(cm), s0[:, 1])
    y = y_f + fl(y_b) + d_skip.astype(jnp.float32)[:, None] * x
    y = y * jax.nn.silu(z.reshape(b, l, H_D, P_D).astype(jnp.float32))
    y = rms_norm(y.reshape(b, l, G_D, GROUP_W // G_D), norm_g.reshape(G_D, GROUP_W // G_D))
    return y.reshape(b, l, GROUP_W).astype(z.dtype), jnp.stack([s_f, s_b], axis=1)


def trunk_layer(x, mod, lw, layer, rope, past):
    shift1, scale1, gate1, shift2, scale2, gate2 = jnp.split(mod[:, None, :].astype(x.dtype), 6, axis=-1)
    h = x * (1 + scale1) + shift1
    parts = jnp.split(h @ lw['w_in'], np.cumsum(SPLIT_SIZES)[:-1].tolist(), axis=-1)
    (a_q, a_k, a_v, b_qkv, b_beta, b_decay, b_gate, c_q, c_kv, c_kr, d_z, d_xbc, d_dt) = parts
    rope_a, rope_c = (None, None) if rope is None else rope
    p = (None,) * 6 if past is None else past
    o_a, ctx_k, ctx_v = mixer_diff(a_q, a_k, a_v, lw['diff_lam'], lw['diff_norm'], layer, rope_a, p[0], p[1])
    o_b, st_b = mixer_deltanet(b_qkv, b_beta, b_decay, b_gate, lw['dn_conv'], lw['dn_a_log'],
                               lw['dn_dt_bias'], lw['dn_norm'], p[2])
    o_c, ctx_ckv, ctx_kr = mixer_mla(c_q, c_kv, c_kr, lw['mla_q_norm'], lw['mla_kv_norm'], lw['mla_w_uq'],
                                     lw['mla_w_uk'], lw['mla_w_uv'], rope_c, p[3], p[4])
    o_d, st_d = mixer_ssd(d_z, d_xbc, d_dt, lw['ssm_conv_w'], lw['ssm_conv_b'], lw['ssm_a_log'],
                          lw['ssm_dt_bias'], lw['ssm_d'], lw['ssm_norm'], p[5])
    mixed = jnp.concatenate([o_a, o_b, o_c, o_d], axis=-1).astype(x.dtype) @ lw['w_out']
    x = layer_norm(ALPHA * x + gate1 * mixed, lw['ln1_g'], lw['ln1_b'])
    h = x * (1 + scale2) + shift2
    ff = jnp.square(jax.nn.relu(h @ lw['w_ff1'])) @ lw['w_ff2']
    x = layer_norm(ALPHA * x + gate2 * ff, lw['ln2_g'], lw['ln2_b'])
    return x, (ctx_k, ctx_v, st_b, ctx_ckv, ctx_kr, st_d)


def _dt_bias(key, shape):
    dt = jnp.exp(jax.random.uniform(key, shape, jnp.float32, math.log(1e-3), math.log(1e-1)))
    return dt + jnp.log(-jnp.expm1(-dt))


def setup_inputs(seed: int = 0) -> dict:
    key = jax.random.key(seed)
    ks = iter(jax.random.split(key, 40))
    f32 = jnp.float32

    def nrm(shape, s):
        return jax.random.normal(next(ks), shape, f32) * s

    return {
        'x_prompt': nrm((BATCH, SEQ, D_MODEL), 1.0),
        'x_sample': nrm((DEC_BATCH, DEC_SEQ, D_MODEL), 1.0),
        'cache_diff_k': nrm((DEC_BATCH, DEPTH, PAST_LEN, H_A, 2, DQK_A), 1.0),
        'cache_diff_v': nrm((DEC_BATCH, DEPTH, PAST_LEN, H_A, DV_A), 1.0),
        'state_delta': nrm((DEC_BATCH, DEPTH, 2, H_B, DK_B, DV_B), 0.1),
        'cache_mla_ckv': nrm((DEC_BATCH, DEPTH, PAST_LEN, KV_RANK), 1.0),
        'cache_mla_krope': nrm((DEC_BATCH, DEPTH, PAST_LEN, ROPE_C), 1.0),
        'state_ssm': nrm((DEC_BATCH, DEPTH, 2, H_D, P_D, N_D), 0.1),
        'c': nrm((DEC_BATCH, D_MODEL), 1.0),
        'c_ctx': nrm((D_MODEL,), 1.0),
        'w_mod': nrm((DEPTH, D_MODEL, 6 * D_MODEL), D_MODEL ** -0.5),
        'b_mod': nrm((DEPTH, 6 * D_MODEL), 0.02),
        'w_in': nrm((DEPTH, D_MODEL, IN_COLS), D_MODEL ** -0.5),
        'diff_lam': nrm((DEPTH, 4, DQK_A), 0.1),
        'diff_norm': 1.0 + nrm((DEPTH, DV_A), 0.02),
        'dn_conv': nrm((DEPTH, CONV_W, H_B * (2 * DK_B + DV_B)), CONV_W ** -0.5),
        'dn_a_log': jnp.log(jax.random.uniform(next(ks), (DEPTH, 2, H_B), f32, 1.0, 16.0)),
        'dn_dt_bias': _dt_bias(next(ks), (DEPTH, 2, H_B)),
        'dn_norm': 1.0 + nrm((DEPTH, DV_B), 0.02),
        'mla_q_norm': 1.0 + nrm((DEPTH, Q_RANK), 0.02),
        'mla_kv_norm': 1.0 + nrm((DEPTH, KV_RANK), 0.02),
        'mla_w_uq': nrm((DEPTH, Q_RANK, H_C * (NOPE_C + ROPE_C)), Q_RANK ** -0.5),
        'mla_w_uk': nrm((DEPTH, KV_RANK, H_C * NOPE_C), KV_RANK ** -0.5),
        'mla_w_uv': nrm((DEPTH, KV_RANK, H_C * V_C), KV_RANK ** -0.5),
        'ssm_conv_w': nrm((DEPTH, CONV_W, H_D * P_D + 2 * G_D * N_D), CONV_W ** -0.5),
        'ssm_conv_b': nrm((DEPTH, H_D * P_D + 2 * G_D * N_D), 0.02),
        'ssm_a_log': jnp.log(jax.random.uniform(next(ks), (DEPTH, 2, H_D), f32, 1.0, 16.0)),
        'ssm_dt_bias': _dt_bias(next(ks), (DEPTH, 2, H_D)),
        'ssm_d': 1.0 + nrm((DEPTH, H_D), 0.1),
        'ssm_norm': 1.0 + nrm((DEPTH, GROUP_W), 0.02),
        'w_out': nrm((DEPTH, MIX_W, D_MODEL), MIX_W ** -0.5 * BETA_INIT),
        'ln1_g': 1.0 + nrm((DEPTH, D_MODEL), 0.02),
        'ln1_b': nrm((DEPTH, D_MODEL), 0.02),
        'ln2_g': 1.0 + nrm((DEPTH, D_MODEL), 0.02),
        'ln2_b': nrm((DEPTH, D_MODEL), 0.02),
        'w_ff1': nrm((DEPTH, D_MODEL, D_FF), D_MODEL ** -0.5),
        'w_ff2': nrm((DEPTH, D_FF, D_MODEL), D_FF ** -0.5 * BETA_INIT),
    }


def reference(x_prompt, x_sample, cache_diff_k, cache_diff_v, state_delta, cache_mla_ckv, cache_mla_krope,
              state_ssm, c, c_ctx, w_mod, b_mod, w_in, diff_lam, diff_norm, dn_conv, dn_a_log, dn_dt_bias,
              dn_norm, mla_q_norm, mla_kv_norm, mla_w_uq, mla_w_uk, mla_w_uv, ssm_conv_w, ssm_conv_b,
              ssm_a_log, ssm_dt_bias, ssm_d, ssm_norm, w_out, ln1_g, ln1_b, ln2_g, ln2_b, w_ff1, w_ff2):
    lat_len = x_sample.shape[1]
    rope = (rope2d_tables(lat_len, DQK_A), rope2d_tables(lat_len, ROPE_C))
    y_prompt, y_sample = x_prompt, x_sample
    ctx_out = ([], [], [], [], [], [])
    for l in range(DEPTH):
        lw = {
            'w_in': w_in[l], 'diff_lam': diff_lam[l], 'diff_norm': diff_norm[l],
            'dn_conv': dn_conv[l], 'dn_a_log': dn_a_log[l], 'dn_dt_bias': dn_dt_bias[l], 'dn_norm': dn_norm[l],
            'mla_q_norm': mla_q_norm[l], 'mla_kv_norm': mla_kv_norm[l], 'mla_w_uq': mla_w_uq[l],
            'mla_w_uk': mla_w_uk[l], 'mla_w_uv': mla_w_uv[l],
            'ssm_conv_w': ssm_conv_w[l], 'ssm_conv_b': ssm_conv_b[l], 'ssm_a_log': ssm_a_log[l],
            'ssm_dt_bias': ssm_dt_bias[l], 'ssm_d': ssm_d[l], 'ssm_norm': ssm_norm[l],
            'w_out': w_out[l], 'ln1_g': ln1_g[l], 'ln1_b': ln1_b[l], 'ln2_g': ln2_g[l], 'ln2_b': ln2_b[l],
            'w_ff1': w_ff1[l], 'w_ff2': w_ff2[l],
        }
        mod_ctx = jax.nn.silu(c_ctx)[None, :] @ w_mod[l] + b_mod[l]
        mod_lat = jax.nn.silu(c) @ w_mod[l] + b_mod[l]
        y_prompt, ctx_t = trunk_layer(y_prompt, mod_ctx, lw, l, None, None)
        past = (cache_diff_k[:, l], cache_diff_v[:, l], state_delta[:, l],
                cache_mla_ckv[:, l], cache_mla_krope[:, l], state_ssm[:, l])
        y_sample, _ = trunk_layer(y_sample, mod_lat, lw, l, rope, past)
        for store, t in zip(ctx_out, ctx_t):
            store.append(t)
    new_diff_k = jnp.stack(ctx_out[0], axis=1)
    new_diff_v = jnp.stack(ctx_out[1], axis=1)
    new_state_delta = jnp.stack(ctx_out[2], axis=1)
    new_mla_ckv = jnp.stack(ctx_out[3], axis=1)
    new_mla_krope = jnp.stack(ctx_out[4], axis=1)
    new_state_ssm = jnp.stack(ctx_out[5], axis=1)
    return (y_prompt, y_sample, new_diff_k, new_diff_v, new_state_delta, new_mla_ckv, new_mla_krope, new_state_ssm)
```

```cpp
#include <hip/hip_runtime.h>
#include <hip/hip_cooperative_groups.h>
#include <cstdio>
#include <cstring>
namespace cg = cooperative_groups;

#ifndef PROBE_MASK
#define PROBE_MASK 0
#endif
#ifndef MULTI_LAUNCH
#define MULTI_LAUNCH 0
#endif

typedef unsigned short bf16;
typedef short bf16x8 __attribute__((ext_vector_type(8)));
typedef float f32x4 __attribute__((ext_vector_type(4)));
typedef unsigned u32x4 __attribute__((ext_vector_type(4)));
typedef unsigned u32x2 __attribute__((ext_vector_type(2)));

#define NTHR 256
#define NTOK 12288
#define NPROMPT 4096
#define NKROW 12800
#define DM 1024
#define NPROJ 3328
#define DFF 4096
#define KPAD 64
#define LDH (DM + KPAD)
#define LDACT (DFF + KPAD)
#define LDQ (256 + KPAD)
#define LDC (128 + KPAD)
#define SMEM_BYTES 73728
#define ALPHA_F 1.681792830507429f
#define EPS_F 1e-6f
#define LOG2E 1.4426950408889634f

#define C_AQ 0
#define C_AK 256
#define C_AV 512
#define C_BQKV 768
#define C_BBETA 1536
#define C_BDECAY 1544
#define C_BGATE 1552
#define C_CQ 1808
#define C_CKV 2064
#define C_CKR 2192
#define C_DZ 2224
#define C_DXBC 2480
#define C_DDT 3248

#define O_Y 0
#define O_DK 12582912
#define O_DV 16777216
#define O_SD 20971520
#define O_CKV 23068672
#define O_KR 25165824
#define O_SS 25690112

struct P {
  const float* in[37];
  float* out;
  bf16 *winT, *woutT, *wff1T, *wff2T, *wuqT, *wukvT;
  float *mod, *ropeC, *ropeS;
  bf16 *hbf, *proj, *act;
  bf16 *qd, *kd, *vtd, *cqn, *qm, *ckv, *kr, *knope, *vtm;
  bf16 *dq, *dk, *dv; float *dbeta, *dg;
  bf16 *sx, *sb, *sc; float *sdt;
  bf16 *pu, *pw, *pqd, *pqk, *pkd; float *pgl;
  bf16 *pst, *pcd; float *plast;
  bf16 *of, *ob, *ao; float *yf, *yb;
  unsigned* bar;
};

typedef __bf16 hbf16x2 __attribute__((ext_vector_type(2)));
typedef float f32x2 __attribute__((ext_vector_type(2)));
__device__ __forceinline__ bf16 f2bf(float f) { __bf16 h = (__bf16)f; return __builtin_bit_cast(bf16, h); }
__device__ __forceinline__ float bf2f(bf16 h) { return __uint_as_float(((unsigned)h) << 16); }
__device__ __forceinline__ unsigned pack2(float a, float b) { f32x2 v = {a, b}; return __builtin_bit_cast(unsigned, __builtin_convertvector(v, hbf16x2)); }
__device__ __forceinline__ float lo2f(unsigned u) { return __uint_as_float(u << 16); }
__device__ __forceinline__ float hi2f(unsigned u) { return __uint_as_float(u & 0xffff0000u); }
__device__ __forceinline__ bf16x8 pack8(f32x4 a, f32x4 b) {
  u32x4 r; r[0] = pack2(a[0], a[1]); r[1] = pack2(a[2], a[3]); r[2] = pack2(b[0], b[1]); r[3] = pack2(b[2], b[3]);
  return __builtin_bit_cast(bf16x8, r);
}
__device__ __forceinline__ f32x4 mfma(bf16x8 a, bf16x8 b, f32x4 c) { return __builtin_amdgcn_mfma_f32_16x16x32_bf16(a, b, c, 0, 0, 0); }
__device__ __forceinline__ float ex2(float x) { return __builtin_amdgcn_exp2f(x); }
__device__ __forceinline__ float siluf(float x) { return x / (1.f + __expf(-x)); }
__device__ __forceinline__ float sigmoidf_(float x) { return 1.f / (1.f + __expf(-x)); }
__device__ __forceinline__ float softplusf_(float x) { return x > 20.f ? x : log1pf(__expf(x)); }
__device__ __forceinline__ int get_tid() { int t = threadIdx.x; asm volatile("" : "+v"(t)); return t; }
__device__ __forceinline__ float wave_sum(float v) {
#pragma unroll
  for (int o = 32; o >= 1; o >>= 1) v += __shfl_xor(v, o);
  return v;
}
__device__ __forceinline__ int permk(int k) { int kk = k & 31; return (k & ~31) + 8 * ((kk & 15) >> 2) + (kk & 3) + ((kk >> 4) << 2); }

__device__ __forceinline__ void tok_info(int r, int& seq, int& pos, int& L, int& krow, int& modi) {
  if (r < NPROMPT) { seq = r >> 8; pos = r & 255; L = 256; krow = r; modi = 0; }
  else { int rr = r - NPROMPT; int b = rr >> 12; seq = 16 + b; pos = rr & 4095; L = 4096; krow = NPROMPT + b * 4352 + pos; modi = 1 + b; }
}
__device__ __forceinline__ void seq_info(int seq, int& row0, int& L, int& krow0, int& Lk, long& vtbase) {
  if (seq < 16) { row0 = seq * 256; L = 256; krow0 = row0; Lk = 256; vtbase = (long)seq * 65536; }
  else { int b = seq - 16; row0 = NPROMPT + b * 4096; L = 4096; krow0 = NPROMPT + b * 4352; Lk = 4352; vtbase = 1048576L + (long)b * (256L * 4352L); }
}


#define XB_TMO      128
#define XB_XCNT(j)  (256  + 64 * (j))
#define XB_XSUB(j)  (1280 + 64 * (j))
#define XB_XGEN(j)  (2304 + 64 * (j))
#define XB_TOP      3328
#define XB_TOPGEN   3392
#define XCD_BAR_WORDS 3456
#define XB_SPIN_CAP (1u << 20)
#define LAS __attribute__((address_space(3)))
__device__ __forceinline__ unsigned xb_ld(unsigned* p)              { return __hip_atomic_load(p, __ATOMIC_RELAXED, __HIP_MEMORY_SCOPE_AGENT); }
__device__ __forceinline__ unsigned xb_add(unsigned* p, unsigned v) { return __hip_atomic_fetch_add(p, v, __ATOMIC_RELAXED, __HIP_MEMORY_SCOPE_AGENT); }
__device__ __forceinline__ unsigned xb_xcc_id() { return (unsigned)__builtin_amdgcn_s_getreg((3 << 11) | 20) & 0xFu; }
#define XB_SPIN(cond, bar) do { unsigned _sp = 0; while (cond) { __builtin_amdgcn_s_sleep(1); \
    if ((++_sp & 255u) == 0u) { if (xb_ld(&(bar)[XB_TMO])) break; if (_sp > XB_SPIN_CAP) { atomicAdd(&(bar)[XB_TMO], 1u); break; } } } } while (0)
struct XcdBarrier { unsigned* bar; unsigned x; volatile LAS unsigned* st; };
__device__ __forceinline__ XcdBarrier xcd_barrier_post(unsigned* bar, volatile LAS unsigned* st) {
  XcdBarrier b; b.bar = bar; b.x = xb_xcc_id(); b.st = st;
  if (threadIdx.x == 0) (void)xb_add(&bar[XB_XCNT(b.x)], 1u);
  return b;
}
__device__ __forceinline__ void xcd_barrier_complete(unsigned* bar, unsigned x, unsigned& nloc, unsigned& nx) {
  const unsigned G = gridDim.x * gridDim.y * gridDim.z;
  unsigned sum, cnt, mine, sp = 0u;
  for (;;) {
    sum = 0u; cnt = 0u; mine = 0u;
#pragma unroll
    for (unsigned j = 0; j < 16; ++j) { const unsigned c = xb_ld(&bar[XB_XCNT(j)]); sum += c; cnt += (c > 0u) ? 1u : 0u; mine = (j == x) ? c : mine; }
    if (sum == G) break;
    __builtin_amdgcn_s_sleep(1);
    if ((++sp & 255u) == 0u) { if (xb_ld(&bar[XB_TMO])) break; if (sp > XB_SPIN_CAP) { atomicAdd(&bar[XB_TMO], 1u); break; } }
  }
  nloc = mine > 0u ? mine : 1u; nx = cnt > 0u ? cnt : 1u;
}
__device__ __forceinline__ void xcd_barrier(const XcdBarrier& b) {
  asm volatile("s_waitcnt vmcnt(0)" ::: "memory");
  __syncthreads();
  if (threadIdx.x == 0) {
    unsigned* bar = b.bar;
    __builtin_amdgcn_s_waitcnt(0);
    unsigned nloc = b.st[0], nx = b.st[1];
    if (nloc == 0u) { xcd_barrier_complete(bar, b.x, nloc, nx); b.st[0] = nloc; b.st[1] = nx; }
    const unsigned old = xb_add(&bar[XB_XSUB(b.x)], 1u);
    const unsigned gen = old / nloc;
    if (old + 1u == (gen + 1u) * nloc) {
      __builtin_amdgcn_fence(__ATOMIC_RELEASE, "agent");
      asm volatile("s_waitcnt vmcnt(0)" ::: "memory");
      const unsigned og = xb_add(&bar[XB_TOP], 1u);
      const unsigned tg = og / nx;
      if (og + 1u == (tg + 1u) * nx) xb_add(&bar[XB_TOPGEN], 1u);
      else XB_SPIN(xb_ld(&bar[XB_TOPGEN]) == tg, bar);
      __builtin_amdgcn_fence(__ATOMIC_ACQUIRE, "agent");
      xb_add(&bar[XB_XGEN(b.x)], 1u);
      asm volatile("s_waitcnt vmcnt(0)" ::: "memory");
    } else {
      XB_SPIN(xb_ld(&bar[XB_XGEN(b.x)]) == gen, bar);
      __builtin_amdgcn_fence(__ATOMIC_ACQUIRE, "agent");
      asm volatile("s_waitcnt vmcnt(0)" ::: "memory");
    }
  }
  __syncthreads();
}

#define GSTR 144
template <class Epi>
__device__ __forceinline__ void gemm_tile(const bf16* __restrict__ A, int lda, const bf16* __restrict__ Bt, int ldb, int K,
                                          int m0, int n0, char* smem, Epi epi) {
  const int tid = get_tid(), lane = tid & 63, w = tid >> 6, g = lane >> 4, lr = lane & 15;
  const int wm = w >> 1, wn = w & 1;
  constexpr int GT = 128 * 128;
  constexpr int GBUF = 2 * GT;
  f32x4 acc[4][4];
#pragma unroll
  for (int i = 0; i < 4; ++i)
#pragma unroll
    for (int j = 0; j < 4; ++j) acc[i][j] = (f32x4){0.f, 0.f, 0.f, 0.f};
  const int nk = K >> 6;
  const int srow = 8 * w + (lane >> 3);
  const int spc = (lane & 7) ^ ((srow >> 1) & 7);
  const bf16* Ag = A + (long)(m0 + srow) * lda + spc * 8;
  const bf16* Bg = Bt + (long)(n0 + srow) * ldb + spc * 8;
  const long a32 = (long)32 * lda, b32 = (long)32 * ldb;
  typedef __attribute__((address_space(3))) unsigned lds_u32;
#define G_ISSUE(BUF, KT) { _Pragma("unroll") for (int i = 0; i < 4; ++i) { \
    __builtin_amdgcn_global_load_lds((const unsigned*)(Ag + i * a32 + (KT) * 64), (lds_u32*)(smem + (BUF) * GBUF + (i * 4 + w) * 1024), 16, 0, 0); \
    __builtin_amdgcn_global_load_lds((const unsigned*)(Bg + i * b32 + (KT) * 64), (lds_u32*)(smem + (BUF) * GBUF + GT + (i * 4 + w) * 1024), 16, 0, 0); } }
  const int sw = (lr >> 1) & 7;
  G_ISSUE(0, 0);
  asm volatile("s_waitcnt vmcnt(0)" ::: "memory");
  __syncthreads();
  for (int kt = 0; kt < nk; ++kt) {
    const int cur = kt & 1;
    if (kt + 1 < nk) G_ISSUE(cur ^ 1, kt + 1);
    bf16x8 a[2][4], b[2][4];
#pragma unroll
    for (int ks = 0; ks < 2; ++ks) {
      const int pc = ((ks * 4 + g) ^ sw) * 16;
#pragma unroll
      for (int i = 0; i < 4; ++i) {
        a[ks][i] = *(const bf16x8*)(smem + cur * GBUF + (wm * 64 + i * 16 + lr) * 128 + pc);
        b[ks][i] = *(const bf16x8*)(smem + cur * GBUF + GT + (wn * 64 + i * 16 + lr) * 128 + pc);
      }
    }
    __builtin_amdgcn_sched_barrier(0);
#pragma unroll
    for (int ks = 0; ks < 2; ++ks)
#pragma unroll
      for (int i = 0; i < 4; ++i)
#pragma unroll
        for (int j = 0; j < 4; ++j) acc[i][j] = mfma(a[ks][i], b[ks][j], acc[i][j]);
    __builtin_amdgcn_sched_barrier(0);
    asm volatile("s_waitcnt vmcnt(0)" ::: "memory");
    __syncthreads();
  }
#undef G_ISSUE
  if constexpr (Epi::STAGED) {
    char* sC = smem + w * 9216;
#pragma unroll
    for (int i = 0; i < 4; ++i)
#pragma unroll
      for (int j = 0; j < 4; ++j) {
        f32x4 v = epi.transform(m0 + wm * 64 + i * 16 + g * 4, n0 + wn * 64 + j * 16 + lr, acc[i][j]);
#pragma unroll
        for (int q = 0; q < 4; ++q) *(bf16*)(sC + (i * 16 + g * 4 + q) * GSTR + (j * 16 + lr) * 2) = f2bf(v[q]);
      }
#pragma unroll
    for (int q = 0; q < 8; ++q) {
      int id = lane + 64 * q, row = id >> 3, ch = id & 7;
      u32x4 v = *(const u32x4*)(sC + row * GSTR + ch * 16);
      *(u32x4*)(epi.dst + (long)(m0 + wm * 64 + row) * epi.ld + n0 + wn * 64 + ch * 8) = v;
    }
    __syncthreads();
  } else {
#pragma unroll
    for (int i = 0; i < 4; ++i)
#pragma unroll
      for (int j = 0; j < 4; ++j) epi(m0 + wm * 64 + i * 16 + g * 4, n0 + wn * 64 + j * 16 + lr, acc[i][j]);
  }
}

struct Sched { int xcc, rank, nloc, ok; volatile __attribute__((address_space(3))) unsigned* st; };
__device__ __forceinline__ bool sched_tile(const Sched& sc, int MT, int NT, int PW, int iter, int& mt, int& nt) {
  if (!sc.ok) {
    int t = blockIdx.x + iter * gridDim.x;
    if (t >= MT * NT) return false;
    mt = t / NT; nt = t % NT; return true;
  }
  const int m_lo = (sc.xcc * MT) >> 3, m_hi = ((sc.xcc + 1) * MT) >> 3, Mr = m_hi - m_lo;
  int q = sc.rank + iter * sc.nloc;
  if (q >= Mr * NT) return false;
  const int per = Mr * PW, nfull = NT / PW;
  int pnl = q / per, w = PW;
  if (pnl >= nfull) { pnl = nfull; w = NT - nfull * PW; }
  const int within = q - pnl * per;
  mt = m_lo + within / w; nt = pnl * PW + within % w;
  return true;
}

__device__ __forceinline__ void pre_item(const P& p, int item, char* smem) {
  const int tid = get_tid();
  if (item == 192) {
    for (int i = tid; i < 512; i += NTHR) {
      int pos = i >> 3, f = i & 7;
      float inv = expf(-(float)f * 0.125f * 9.210340371976184f);
      float s, c; sincosf((float)pos * inv, &s, &c);
      p.ropeC[i] = c; p.ropeS[i] = s;
    }
    return;
  }
  const int l = item / 48, cgp = item % 48, c0 = cgp * 128;
  float* sv = (float*)smem;
  float* red = (float*)(smem + 12288);
  for (int i = tid; i < 3072; i += NTHR) {
    int m = i >> 10, k = i & 1023;
    float x = (m == 0) ? p.in[9][k] : p.in[8][(m - 1) * 1024 + k];
    sv[i] = siluf(x);
  }
  __syncthreads();
  const int cl = tid & 31, ksub = tid >> 5;
  float acc[3][4];
#pragma unroll
  for (int m = 0; m < 3; ++m)
#pragma unroll
    for (int j = 0; j < 4; ++j) acc[m][j] = 0.f;
  const float* wp = p.in[10] + (long)l * 1024 * 6144 + c0 + cl * 4;
#pragma unroll 4
  for (int k = ksub; k < 1024; k += 8) {
    f32x4 w4 = __builtin_nontemporal_load((const f32x4*)(wp + (long)k * 6144));
    float s0 = sv[k], s1 = sv[1024 + k], s2 = sv[2048 + k];
#pragma unroll
    for (int j = 0; j < 4; ++j) { acc[0][j] += s0 * w4[j]; acc[1][j] += s1 * w4[j]; acc[2][j] += s2 * w4[j]; }
  }
#pragma unroll
  for (int m = 0; m < 3; ++m)
#pragma unroll
    for (int j = 0; j < 4; ++j) red[(ksub * 3 + m) * 128 + cl * 4 + j] = acc[m][j];
  __syncthreads();
  for (int i = tid; i < 384; i += NTHR) {
    int m = i >> 7, c = i & 127;
    float s = 0.f;
#pragma unroll
    for (int q = 0; q < 8; ++q) s += red[(q * 3 + m) * 128 + c];
    p.mod[((long)l * 3 + m) * 6144 + c0 + c] = s + p.in[11][l * 6144 + c0 + c];
  }
  __syncthreads();
}

__device__ __forceinline__ void wconv_tile(const float* __restrict__ W, int K, int N, bf16* __restrict__ Wt, int kt, int nt, char* smem) {
  float* T = (float*)smem;
  const int tid = get_tid();
  {
    int kk = tid >> 2, cc = (tid & 3) * 16;
#pragma unroll
    for (int q = 0; q < 4; ++q) {
      int n = nt * 64 + cc + q * 4;
      f32x4 v = (f32x4){0.f, 0.f, 0.f, 0.f};
      if (n < N) v = __builtin_nontemporal_load((const f32x4*)(W + (long)(kt * 64 + kk) * N + n));
#pragma unroll
      for (int j = 0; j < 4; ++j) T[kk * 65 + cc + q * 4 + j] = v[j];
    }
  }
  __syncthreads();
  {
    int n = tid >> 2, kc = (tid & 3) * 16;
    u32x4 o0, o1;
#pragma unroll
    for (int q = 0; q < 4; ++q) {
      o0[q] = pack2(T[(kc + 2 * q) * 65 + n], T[(kc + 2 * q + 1) * 65 + n]);
      o1[q] = pack2(T[(kc + 8 + 2 * q) * 65 + n], T[(kc + 8 + 2 * q + 1) * 65 + n]);
    }
    bf16* dst = Wt + (long)(nt * 64 + n) * (K + KPAD) + kt * 64 + kc;
    *(u32x4*)dst = o0;
    *(u32x4*)(dst + 8) = o1;
  }
  __syncthreads();
}

#define WC_IN 832
#define WC_OUT 256
#define WC_FF1 1024
#define WC_FF2 1024
#define WC_UQ 24
#define WC_UK 8
#define WC_UV 8
#define WC_TOTAL (WC_IN + WC_OUT + WC_FF1 + WC_FF2 + WC_UQ + WC_UK + WC_UV)

__device__ __forceinline__ void wconv_item(const P& p, int l, int it, char* smem) {
  const float* W; int K, N, ntn; bf16* Wt;
  if (it < WC_IN) { W = p.in[12] + (long)l * 1024 * 3256; K = 1024; N = 3256; Wt = p.winT; ntn = 52; }
  else if ((it -= WC_IN) < WC_OUT) { W = p.in[30] + (long)l * 1024 * 1024; K = 1024; N = 1024; Wt = p.woutT; ntn = 16; }
  else if ((it -= WC_OUT) < WC_FF1) { W = p.in[35] + (long)l * 1024 * 4096; K = 1024; N = 4096; Wt = p.wff1T; ntn = 64; }
  else if ((it -= WC_FF1) < WC_FF2) { W = p.in[36] + (long)l * 4096 * 1024; K = 4096; N = 1024; Wt = p.wff2T; ntn = 16; }
  else if ((it -= WC_FF2) < WC_UQ) { W = p.in[21] + (long)l * 256 * 384; K = 256; N = 384; Wt = p.wuqT; ntn = 6; }
  else if ((it -= WC_UQ) < WC_UK) { W = p.in[22] + (long)l * 128 * 256; K = 128; N = 256; Wt = p.wukvT; ntn = 4; }
  else { it -= WC_UK; W = p.in[23] + (long)l * 128 * 256; K = 128; N = 256; Wt = p.wukvT + 256 * LDC; ntn = 4; }
  wconv_tile(W, K, N, Wt, it / ntn, it % ntn, smem);
}

__device__ __forceinline__ void lnmod_rows(const P& p, int item, int mode, const float* lg, const float* lb, int l, int shift_idx, int scale_idx) {
  constexpr int LNR = 2;
  const int tid_ = get_tid(); const int lane = tid_ & 63, w = tid_ >> 6;
  const int rbase = item * (4 * LNR) + w * LNR;
  f32x4 v[LNR][4];
  if (mode == 0) {
#pragma unroll
    for (int q = 0; q < LNR; ++q) {
      const int r = rbase + q;
      const float* src = (r < NPROMPT) ? (p.in[0] + (long)r * DM) : (p.in[1] + (long)(r - NPROMPT) * DM);
#pragma unroll
      for (int i = 0; i < 4; ++i) v[q][i] = *(const f32x4*)(src + lane * 4 + 256 * i);
    }
  } else {
    u32x2 u[LNR][4];
#pragma unroll
    for (int q = 0; q < LNR; ++q)
#pragma unroll
      for (int i = 0; i < 4; ++i) u[q][i] = *(const u32x2*)((const bf16*)p.out + (long)(rbase + q) * 2048 + 1024 + lane * 4 + 256 * i);
    f32x4 gg[4], bb[4];
#pragma unroll
    for (int i = 0; i < 4; ++i) { gg[i] = *(const f32x4*)(lg + lane * 4 + 256 * i); bb[i] = *(const f32x4*)(lb + lane * 4 + 256 * i); }
#pragma unroll
    for (int q = 0; q < LNR; ++q) {
#pragma unroll
      for (int i = 0; i < 4; ++i) { v[q][i][0] = lo2f(u[q][i][0]); v[q][i][1] = hi2f(u[q][i][0]); v[q][i][2] = lo2f(u[q][i][1]); v[q][i][3] = hi2f(u[q][i][1]); }
      float s = 0.f;
#pragma unroll
      for (int i = 0; i < 4; ++i) s += v[q][i][0] + v[q][i][1] + v[q][i][2] + v[q][i][3];
      s = wave_sum(s);
      const float mu = s * (1.f / 1024.f);
      float qq = 0.f;
#pragma unroll
      for (int i = 0; i < 4; ++i)
#pragma unroll
        for (int j = 0; j < 4; ++j) { float d = v[q][i][j] - mu; qq += d * d; }
      qq = wave_sum(qq);
      const float rs = rsqrtf(qq * (1.f / 1024.f) + EPS_F);
#pragma unroll
      for (int i = 0; i < 4; ++i)
#pragma unroll
        for (int j = 0; j < 4; ++j) v[q][i][j] = (v[q][i][j] - mu) * rs * gg[i][j] + bb[i][j];
    }
  }
  if (mode == 2) {
#pragma unroll
    for (int q = 0; q < LNR; ++q)
#pragma unroll
      for (int i = 0; i < 4; ++i) *(f32x4*)(p.out + (long)(rbase + q) * DM + lane * 4 + 256 * i) = v[q][i];
    return;
  }
  const int modi = (rbase < NPROMPT) ? 0 : 1 + ((rbase - NPROMPT) >> 12);
  const float* md = p.mod + ((long)l * 3 + modi) * 6144;
  f32x4 sh[4], scl[4];
#pragma unroll
  for (int i = 0; i < 4; ++i) { sh[i] = *(const f32x4*)(md + shift_idx * 1024 + lane * 4 + 256 * i); scl[i] = *(const f32x4*)(md + scale_idx * 1024 + lane * 4 + 256 * i); }
#pragma unroll
  for (int q = 0; q < LNR; ++q) {
    const int r = rbase + q;
    bf16* rowb = (bf16*)p.out + (long)r * 2048;
#pragma unroll
    for (int i = 0; i < 4; ++i) {
      u32x2 o; o[0] = pack2(v[q][i][0], v[q][i][1]); o[1] = pack2(v[q][i][2], v[q][i][3]);
      *(u32x2*)(rowb + lane * 4 + 256 * i) = o;
      u32x2 h;
      h[0] = pack2(v[q][i][0] * (1.f + scl[i][0]) + sh[i][0], v[q][i][1] * (1.f + scl[i][1]) + sh[i][1]);
      h[1] = pack2(v[q][i][2] * (1.f + scl[i][2]) + sh[i][2], v[q][i][3] * (1.f + scl[i][3]) + sh[i][3]);
      *(u32x2*)(p.hbf + (long)r * LDH + lane * 4 + 256 * i) = h;
    }
  }
}

__device__ __forceinline__ void rope_cs(const P& p, int pos, int d, float& c, float& s) {
  int q = d >> 3, f = d & 7;
  int pp = (q < 2) ? (pos >> 6) : (pos & 63);
  c = p.ropeC[pp * 8 + f]; s = p.ropeS[pp * 8 + f];
}

#define PT 32
#define NT_OWN (NTOK / PT)
#define NT_PAST (512 / PT)
__device__ __forceinline__ void prep_diff(const P& p, int l, int tile) {
  const int tid = get_tid();
  const bool past = tile >= NT_OWN;
  int r0 = 0, seq, pos0, L, krow0, modi;
  const float* ck = nullptr; const float* cv = nullptr;
  if (!past) { r0 = tile * PT; tok_info(r0, seq, pos0, L, krow0, modi); }
  else {
    int b = (tile - NT_OWN) / (256 / PT), j0 = ((tile - NT_OWN) % (256 / PT)) * PT;
    seq = 16 + b; pos0 = 4096 + j0; krow0 = NPROMPT + b * 4352 + 4096 + j0;
    ck = p.in[2] + ((long)(b * 4 + l) * 256 + j0) * 256;
    cv = p.in[3] + ((long)(b * 4 + l) * 256 + j0) * 256;
  }
  const bool sample = seq >= 16;
  const int d = tid & 31, qd = d >> 3;
  const float sg = (qd & 1) ? 1.f : -1.f;
  for (int i0 = 0; i0 < PT; i0 += 8) {
    if (!past) {
      float q[8], k[8], qp[8], kp[8];
#pragma unroll
      for (int t = 0; t < 8; ++t) {
        const bf16* pr = p.proj + (long)(r0 + i0 + t) * NPROJ;
        q[t] = bf2f(pr[C_AQ + tid]); k[t] = bf2f(pr[C_AK + tid]);
        qp[t] = bf2f(pr[C_AQ + (tid ^ 8)]); kp[t] = bf2f(pr[C_AK + (tid ^ 8)]);
      }
#pragma unroll
      for (int t = 0; t < 8; ++t) {
        const int i = i0 + t;
        float qq = q[t], kk = k[t];
        if (!sample) {
          p.out[O_DK + ((long)(seq * 4 + l) * 256 + pos0 + i) * 256 + tid] = kk;
        } else {
          float c, sn; rope_cs(p, pos0 + i, d, c, sn);
          qq = qq * c + sg * qp[t] * sn;
          kk = kk * c + sg * kp[t] * sn;
        }
        p.qd[(long)(r0 + i) * 256 + tid] = f2bf(qq * (0.17677669529663687f * LOG2E));
        p.kd[(long)(krow0 + i) * 256 + tid] = f2bf(kk);
      }
    } else {
      float k[8];
#pragma unroll
      for (int t = 0; t < 8; ++t) k[t] = ck[(i0 + t) * 256 + tid];
#pragma unroll
      for (int t = 0; t < 8; ++t) p.kd[(long)(krow0 + i0 + t) * 256 + tid] = f2bf(k[t]);
    }
  }
  int row0s, Ls, krow0s, Lk; long vtbase;
  seq_info(seq, row0s, Ls, krow0s, Lk, vtbase);
  const int key0 = pos0;
  for (int o0 = 0; o0 < PT / 8; o0 += 4) {
    float vv[4][8];
#pragma unroll
    for (int o = 0; o < 4; ++o)
#pragma unroll
      for (int j = 0; j < 8; ++j) {
        if (!past) vv[o][j] = bf2f(p.proj[(long)(r0 + (o0 + o) * 8 + j) * NPROJ + C_AV + tid]);
        else vv[o][j] = cv[((o0 + o) * 8 + j) * 256 + tid];
      }
#pragma unroll
    for (int o = 0; o < 4; ++o) {
      if (!past && !sample) {
#pragma unroll
        for (int j = 0; j < 8; ++j) p.out[O_DV + ((long)(seq * 4 + l) * 256 + pos0 + (o0 + o) * 8 + j) * 256 + tid] = vv[o][j];
      }
      u32x4 pk; pk[0] = pack2(vv[o][0], vv[o][1]); pk[1] = pack2(vv[o][2], vv[o][3]); pk[2] = pack2(vv[o][4], vv[o][5]); pk[3] = pack2(vv[o][6], vv[o][7]);
      *(u32x4*)(p.vtd + vtbase + (long)tid * Lk + key0 + (o0 + o) * 8) = pk;
    }
  }
}

__device__ __forceinline__ void prep_mla(const P& p, int l, int tile) {
  const int tid_ = get_tid(); const int lane = tid_ & 63, w = tid_ >> 6;
  const bool past = tile >= NT_OWN;
  if (!past) {
    const f32x4 gq = *(const f32x4*)(p.in[19] + l * 256 + lane * 4);
    const float kv0 = p.in[20][l * 128 + lane * 2], kv1 = p.in[20][l * 128 + lane * 2 + 1];
    for (int ii0 = 0; ii0 < PT / 4; ii0 += 4) {
      u32x2 cq[4]; unsigned ck[4]; float krv[4];
#pragma unroll
      for (int t = 0; t < 4; ++t) {
        const bf16* pr = p.proj + (long)(tile * PT + (ii0 + t) * 4 + w) * NPROJ;
        cq[t] = *(const u32x2*)(pr + C_CQ + lane * 4);
        ck[t] = *(const unsigned*)(pr + C_CKV + lane * 2);
        krv[t] = bf2f(pr[C_CKR + (lane & 31)]);
      }
#pragma unroll
      for (int t = 0; t < 4; ++t) {
        int r = tile * PT + (ii0 + t) * 4 + w, seq, pos, L, krow, modi;
        tok_info(r, seq, pos, L, krow, modi);
        float a0 = lo2f(cq[t][0]), a1 = hi2f(cq[t][0]), a2 = lo2f(cq[t][1]), a3 = hi2f(cq[t][1]);
        float ss = wave_sum(a0 * a0 + a1 * a1 + a2 * a2 + a3 * a3);
        float rs = rsqrtf(ss * (1.f / 256.f) + EPS_F);
        u32x2 oq; oq[0] = pack2(a0 * rs * gq[0], a1 * rs * gq[1]); oq[1] = pack2(a2 * rs * gq[2], a3 * rs * gq[3]);
        *(u32x2*)(p.cqn + (long)r * LDQ + lane * 4) = oq;
        float b0 = lo2f(ck[t]), b1 = hi2f(ck[t]);
        float s2 = wave_sum(b0 * b0 + b1 * b1);
        float rs2 = rsqrtf(s2 * (1.f / 128.f) + EPS_F);
        b0 = b0 * rs2 * kv0; b1 = b1 * rs2 * kv1;
        *(unsigned*)(p.ckv + (long)krow * LDC + lane * 2) = pack2(b0, b1);
        float kr = krv[t];
        float kp = __shfl_xor(kr, 8);
        if (seq < 16) {
          long o = ((long)(seq * 4 + l) * 256 + pos);
          p.out[O_CKV + o * 128 + lane * 2] = b0; p.out[O_CKV + o * 128 + lane * 2 + 1] = b1;
          if (lane < 32) p.out[O_KR + o * 32 + lane] = kr;
        } else {
          float c, sn; rope_cs(p, pos, lane & 31, c, sn);
          float sg = ((lane >> 3) & 1) ? 1.f : -1.f;
          kr = kr * c + sg * kp * sn;
        }
        if (lane < 32) p.kr[(long)krow * 32 + lane] = f2bf(kr);
      }
    }
  } else {
    const int b = (tile - NT_OWN) / (256 / PT), j0 = ((tile - NT_OWN) % (256 / PT)) * PT;
    for (int ii0 = 0; ii0 < PT / 4; ii0 += 4) {
      float c1a[4], c1b[4], c2v[4];
#pragma unroll
      for (int t = 0; t < 4; ++t) {
        const int j = j0 + (ii0 + t) * 4 + w;
        const float* c1 = p.in[5] + ((long)(b * 4 + l) * 256 + j) * 128;
        const float* c2 = p.in[6] + ((long)(b * 4 + l) * 256 + j) * 32;
        c1a[t] = c1[lane * 2]; c1b[t] = c1[lane * 2 + 1]; c2v[t] = c2[lane & 31];
      }
#pragma unroll
      for (int t = 0; t < 4; ++t) {
        const int j = j0 + (ii0 + t) * 4 + w;
        const int krow = NPROMPT + b * 4352 + 4096 + j;
        *(unsigned*)(p.ckv + (long)krow * LDC + lane * 2) = pack2(c1a[t], c1b[t]);
        if (lane < 32) p.kr[(long)krow * 32 + lane] = f2bf(c2v[t]);
      }
    }
  }
}

__device__ __forceinline__ void prep_dn(const P& p, int l, int tile) {
  const int tid = get_tid();
  const int r0 = tile * PT;
  int seq, pos0, L, krow, modi;
  tok_info(r0, seq, pos0, L, krow, modi);
  const float* cw = p.in[15] + (long)l * 3 * 768;
  float w0[3], w1[3], w2[3];
#pragma unroll
  for (int c = 0; c < 3; ++c) { w0[c] = cw[c * 256 + tid]; w1[c] = cw[768 + c * 256 + tid]; w2[c] = cw[1536 + c * 256 + tid]; }
  const float alog = __expf(p.in[16][l * 8 + (tid & 7)]), dtb = p.in[17][l * 8 + (tid & 7)];
  const bf16* pj = p.proj + C_BQKV + tid;
  for (int i0 = 0; i0 < PT; i0 += 16) {
    float v[3][18];
#pragma unroll
    for (int t = 0; t < 18; ++t) {
      const int pos = pos0 + i0 + t - 1;
      const bool ok = (pos >= 0) && (pos < L) && (i0 + t - 1 >= 0 || pos0 > 0);
      const int rr = ok ? (r0 + i0 + t - 1) : r0;
#pragma unroll
      for (int c = 0; c < 3; ++c) { float x = bf2f(pj[(long)rr * NPROJ + c * 256]); v[c][t] = ok ? x : 0.f; }
    }
    float braw[16], draw[16];
#pragma unroll
    for (int t = 0; t < 16; ++t) {
      const bf16* pr = p.proj + (long)(r0 + i0 + t) * NPROJ;
      braw[t] = bf2f(pr[C_BBETA + (tid & 7)]); draw[t] = bf2f(pr[C_BDECAY + (tid & 7)]);
    }
#pragma unroll
    for (int t = 0; t < 16; ++t) {
      float y[3];
#pragma unroll
      for (int c = 0; c < 3; ++c) y[c] = siluf(w0[c] * v[c][t] + w1[c] * v[c][t + 1] + w2[c] * v[c][t + 2]);
      float sq = wave_sum(y[0] * y[0]);
      float sk = wave_sum(y[1] * y[1]);
      long o = (long)(r0 + i0 + t) * 256 + tid;
      p.dq[o] = f2bf(y[0] * rsqrtf(sq + EPS_F) * 0.125f); p.dk[o] = f2bf(y[1] * rsqrtf(sk + EPS_F)); p.dv[o] = f2bf(y[2]);
      if (tid < 8) {
        p.dbeta[(long)(r0 + i0 + t) * 8 + tid] = sigmoidf_(braw[t]);
        p.dg[(long)(r0 + i0 + t) * 8 + tid] = -alog * softplusf_(draw[t] + dtb);
      }
    }
  }
}

__device__ __forceinline__ void prep_ssd(const P& p, int l, int tile) {
  const int tid = get_tid();
  const int r0 = tile * PT;
  int seq, pos0, L, krow, modi;
  tok_info(r0, seq, pos0, L, krow, modi);
  const float* cw = p.in[24] + (long)l * 3 * 768;
  const float* cb = p.in[25] + (long)l * 768;
  float w0[3], w1[3], w2[3], bs[3];
#pragma unroll
  for (int c = 0; c < 3; ++c) { w0[c] = cw[c * 256 + tid]; w1[c] = cw[768 + c * 256 + tid]; w2[c] = cw[1536 + c * 256 + tid]; bs[c] = cb[c * 256 + tid]; }
  const float dtb = p.in[27][l * 8 + (tid & 7)];
  const bf16* pj = p.proj + C_DXBC + tid;
  for (int i0 = 0; i0 < PT; i0 += 16) {
    float v[3][18];
#pragma unroll
    for (int t = 0; t < 18; ++t) {
      const int pos = pos0 + i0 + t - 1;
      const bool ok = (pos >= 0) && (pos < L) && (i0 + t - 1 >= 0 || pos0 > 0);
      const int rr = ok ? (r0 + i0 + t - 1) : r0;
#pragma unroll
      for (int c = 0; c < 3; ++c) { float x = bf2f(pj[(long)rr * NPROJ + c * 256]); v[c][t] = ok ? x : 0.f; }
    }
    float draw[16];
#pragma unroll
    for (int t = 0; t < 16; ++t) draw[t] = bf2f(p.proj[(long)(r0 + i0 + t) * NPROJ + C_DDT + (tid & 7)]);
#pragma unroll
    for (int t = 0; t < 16; ++t) {
      long o = (long)(r0 + i0 + t) * 256 + tid;
      p.sx[o] = f2bf(siluf(w0[0] * v[0][t] + w1[0] * v[0][t + 1] + w2[0] * v[0][t + 2] + bs[0]));
      p.sb[o] = f2bf(siluf(w0[1] * v[1][t] + w1[1] * v[1][t + 1] + w2[1] * v[1][t + 2] + bs[1]));
      p.sc[o] = f2bf(siluf(w0[2] * v[2][t] + w1[2] * v[2][t + 1] + w2[2] * v[2][t + 2] + bs[2]));
      if (tid < 8) p.sdt[(long)(r0 + i0 + t) * 8 + tid] = softplusf_(draw[t] + dtb);
    }
  }
}

__device__ __forceinline__ void dn_chunk_prep(const P& p, int item, char* smem) {
  const int tid = get_tid(), lane = tid & 63, w = tid >> 6, g = lane >> 4, lr = lane & 15;
  const int dir = item & 1, h = (item >> 1) & 3, cgi = item >> 3;
  const int r0 = cgi * 64;
  char* sQ = smem; char* sK = smem + 9216; char* sV = smem + 18432;
  float* sA = (float*)(smem + 27648);
  bf16* sQKM = (bf16*)(smem + 44032);
  bf16* sW = (bf16*)(smem + 52224);
  float* sGc = (float*)(smem + 60416);
  float* sBeta = (float*)(smem + 60672);
  for (int id = tid; id < 512; id += NTHR) {
    int i = id >> 3, ch = id & 7;
    int r = r0 + (dir ? 63 - i : i);
    long go = (long)r * 256 + h * 64 + ch * 8;
    *(u32x4*)(sQ + i * 144 + ch * 16) = *(const u32x4*)(p.dq + go);
    *(u32x4*)(sK + i * 144 + ch * 16) = *(const u32x4*)(p.dk + go);
    *(u32x4*)(sV + i * 144 + ch * 16) = *(const u32x4*)(p.dv + go);
  }
  if (w == 0) {
    int r = r0 + (dir ? 63 - lane : lane);
    float gv = p.dg[(long)r * 8 + dir * 4 + h];
    sBeta[lane] = p.dbeta[(long)r * 8 + dir * 4 + h];
#pragma unroll
    for (int o = 1; o < 64; o <<= 1) { float t = __shfl_up(gv, o); if (lane >= o) gv += t; }
    sGc[lane] = gv;
  }
  __syncthreads();
  const float gl = sGc[63];
  if (tid == 0) p.pgl[item] = gl;
  {
    bf16x8 aK[2], aQ[2];
#pragma unroll
    for (int ks = 0; ks < 2; ++ks) {
      aK[ks] = *(const bf16x8*)(sK + (16 * w + lr) * 144 + ks * 64 + g * 16);
      aQ[ks] = *(const bf16x8*)(sQ + (16 * w + lr) * 144 + ks * 64 + g * 16);
    }
#pragma unroll
    for (int nt = 0; nt < 4; ++nt) {
      f32x4 kk = (f32x4){0.f, 0.f, 0.f, 0.f}, qk = (f32x4){0.f, 0.f, 0.f, 0.f};
#pragma unroll
      for (int ks = 0; ks < 2; ++ks) {
        bf16x8 bK = *(const bf16x8*)(sK + (16 * nt + lr) * 144 + ks * 64 + g * 16);
        kk = mfma(aK[ks], bK, kk);
        qk = mfma(aQ[ks], bK, qk);
      }
      const int jj = 16 * nt + lr;
      const float gj = sGc[jj];
#pragma unroll
      for (int j = 0; j < 4; ++j) {
        const int i = 16 * w + 4 * g + j;
        float dec = (i >= jj) ? __expf(sGc[i] - gj) : 0.f;
        sA[i * 64 + jj] = (i > jj) ? sBeta[i] * kk[j] * dec : 0.f;
        sQKM[i * 64 + permk(jj)] = f2bf(qk[j] * dec);
      }
    }
  }
  const long ob = (long)item * 4096;
  __syncthreads();
  if (tid < 128) {
    const int c = tid & 63;
    const bool isw = tid >= 64;
    const char* src = isw ? sK : sV;
    float acol[64], x[64];
#pragma unroll
    for (int i = 0; i < 64; ++i) acol[i] = sA[i * 64 + lane];
#pragma unroll
    for (int i = 0; i < 64; ++i) {
      float r = bf2f(*(const bf16*)(src + i * 144 + c * 2)) * sBeta[i];
      x[i] = isw ? r * __expf(sGc[i]) : r;
    }
#pragma unroll
    for (int i = 1; i < 64; ++i) {
      float acc0 = x[i], acc1 = 0.f;
#pragma unroll
      for (int j = 0; j < i; ++j) {
        const float a = __builtin_bit_cast(float, __builtin_amdgcn_readlane(__builtin_bit_cast(int, acol[i]), j));
        if (j & 1) acc1 -= a * x[j]; else acc0 -= a * x[j];
      }
      x[i] = acc0 + acc1;
    }
    if (!isw) {
#pragma unroll
      for (int q = 0; q < 8; ++q) {
        u32x4 o;
        o[0] = pack2(x[q * 8 + 0], x[q * 8 + 1]); o[1] = pack2(x[q * 8 + 2], x[q * 8 + 3]);
        o[2] = pack2(x[q * 8 + 4], x[q * 8 + 5]); o[3] = pack2(x[q * 8 + 6], x[q * 8 + 7]);
        *(u32x4*)(p.pu + ob + c * 64 + q * 8) = o;
      }
    } else {
      const int pc = permk(c);
#pragma unroll
      for (int i = 0; i < 64; ++i) sW[i * 64 + pc] = f2bf(x[i]);
    }
    } else {
    const int t2 = tid - 128;
    for (int id = t2; id < 512; id += 128) {
      int i = id >> 3, c8 = id & 7;
      int blk = (c8 >> 2) * 32, gg = c8 & 3;
      float e = __expf(sGc[i]);
      u32x2 lo = *(const u32x2*)(sQ + i * 144 + (blk + 4 * gg) * 2);
      u32x2 hi = *(const u32x2*)(sQ + i * 144 + (blk + 16 + 4 * gg) * 2);
      u32x4 o;
      o[0] = pack2(lo2f(lo[0]) * e, hi2f(lo[0]) * e); o[1] = pack2(lo2f(lo[1]) * e, hi2f(lo[1]) * e);
      o[2] = pack2(lo2f(hi[0]) * e, hi2f(hi[0]) * e); o[3] = pack2(lo2f(hi[1]) * e, hi2f(hi[1]) * e);
      *(u32x4*)(p.pqd + ob + i * 64 + c8 * 8) = o;
    }
    for (int id = t2; id < 512; id += 128) {
      int d = id >> 3, c8 = id & 7;
      int blk = (c8 >> 2) * 32, gg = c8 & 3;
      float vals[8];
#pragma unroll
      for (int e = 0; e < 8; ++e) {
        int i = blk + ((e < 4) ? (4 * gg + e) : (16 + 4 * gg + e - 4));
        vals[e] = bf2f(*(const bf16*)(sK + i * 144 + d * 2)) * __expf(gl - sGc[i]);
      }
      u32x4 o; o[0] = pack2(vals[0], vals[1]); o[1] = pack2(vals[2], vals[3]); o[2] = pack2(vals[4], vals[5]); o[3] = pack2(vals[6], vals[7]);
      *(u32x4*)(p.pkd + ob + d * 64 + c8 * 8) = o;
    }
    for (int id = t2; id < 512; id += 128) *(u32x4*)(p.pqk + ob + id * 8) = *(const u32x4*)(sQKM + id * 8);
  }
  __syncthreads();
  for (int id = tid; id < 512; id += NTHR) *(u32x4*)(p.pw + ob + id * 8) = *(const u32x4*)(sW + id * 8);
  __syncthreads();
}

__device__ __forceinline__ void ssd_chunk_prep(const P& p, int l, int item, char* smem) {
  const int tid = get_tid(), lane = tid & 63, w = tid >> 6, g = lane >> 4, lr = lane & 15;
  const int dir = item & 1, h = (item >> 1) & 3, cgi = item >> 3, gr = h >> 1;
  const int r0 = cgi * 64;
  char* sB = smem; char* sC = smem + 17408; char* sXT = smem + 34816; char* sBT = smem + 44032;
  float* sAc = (float*)(smem + 62464);
  float* sDt = (float*)(smem + 62720);
  if (w == 0) {
    int r = r0 + (dir ? 63 - lane : lane);
    float dt = p.sdt[(long)r * 8 + dir * 4 + h];
    float a = -__expf(p.in[26][l * 8 + dir * 4 + h]);
    float v = dt * a;
#pragma unroll
    for (int o = 1; o < 64; o <<= 1) { float t = __shfl_up(v, o); if (lane >= o) v += t; }
    sAc[lane] = v; sDt[lane] = dt;
  }
  for (int id = tid; id < 1024; id += NTHR) {
    int i = id >> 4, ch = id & 15;
    int r = r0 + (dir ? 63 - i : i);
    long go = (long)r * 256 + gr * 128 + ch * 8;
    *(u32x4*)(sB + i * 272 + ch * 16) = *(const u32x4*)(p.sb + go);
    *(u32x4*)(sC + i * 272 + ch * 16) = *(const u32x4*)(p.sc + go);
  }
  __syncthreads();
  const float last = sAc[63];
  if (tid == 0) p.plast[item] = last;
  for (int id = tid; id < 512; id += NTHR) {
    int i = id >> 3, ch = id & 7;
    int r = r0 + (dir ? 63 - i : i);
    u32x4 v = *(const u32x4*)(p.sx + (long)r * 256 + h * 64 + ch * 8);
    float dt = sDt[i];
#pragma unroll
    for (int q = 0; q < 4; ++q) {
      *(bf16*)(sXT + (ch * 8 + 2 * q) * 144 + i * 2) = f2bf(lo2f(v[q]) * dt);
      *(bf16*)(sXT + (ch * 8 + 2 * q + 1) * 144 + i * 2) = f2bf(hi2f(v[q]) * dt);
    }
  }
  for (int id = tid; id < 1024; id += NTHR) {
    int i = id >> 4, ch = id & 15;
    u32x4 v = *(const u32x4*)(sB + i * 272 + ch * 16);
    float e = __expf(last - sAc[i]);
#pragma unroll
    for (int q = 0; q < 4; ++q) {
      *(bf16*)(sBT + (ch * 8 + 2 * q) * 144 + i * 2) = f2bf(lo2f(v[q]) * e);
      *(bf16*)(sBT + (ch * 8 + 2 * q + 1) * 144 + i * 2) = f2bf(hi2f(v[q]) * e);
    }
  }
  const long ob = (long)item * 8192;
  for (int id = tid; id < 1024; id += NTHR) {
    int i = id >> 4, c8 = id & 15;
    int blk = (c8 >> 2) * 32, gg = c8 & 3;
    float e = __expf(sAc[i]);
    u32x2 lo = *(const u32x2*)(sC + i * 272 + (blk + 4 * gg) * 2);
    u32x2 hi = *(const u32x2*)(sC + i * 272 + (blk + 16 + 4 * gg) * 2);
    u32x4 o;
    o[0] = pack2(lo2f(lo[0]) * e, hi2f(lo[0]) * e); o[1] = pack2(lo2f(lo[1]) * e, hi2f(lo[1]) * e);
    o[2] = pack2(lo2f(hi[0]) * e, hi2f(hi[0]) * e); o[3] = pack2(lo2f(hi[1]) * e, hi2f(hi[1]) * e);
    *(u32x4*)(p.pcd + ob + i * 128 + c8 * 8) = o;
  }
  __syncthreads();
  f32x4 G[4];
#pragma unroll
  for (int mt = 0; mt < 4; ++mt) G[mt] = (f32x4){0.f, 0.f, 0.f, 0.f};
#pragma unroll
  for (int ks = 0; ks < 4; ++ks) {
    bf16x8 bC = *(const bf16x8*)(sC + (16 * w + lr) * 272 + ks * 64 + g * 16);
#pragma unroll
    for (int mt = 0; mt < 4; ++mt) {
      bf16x8 aB = *(const bf16x8*)(sB + (16 * mt + lr) * 272 + ks * 64 + g * 16);
      G[mt] = mfma(aB, bC, G[mt]);
    }
  }
  {
    const int i = 16 * w + lr;
    const float ai = sAc[i];
#pragma unroll
    for (int mt = 0; mt < 4; ++mt)
#pragma unroll
      for (int j = 0; j < 4; ++j) {
        int jj = 16 * mt + 4 * g + j;
        G[mt][j] = (i >= jj) ? G[mt][j] * __expf(ai - sAc[jj]) : 0.f;
      }
  }
  bf16x8 bM[2];
  bM[0] = pack8(G[0], G[1]); bM[1] = pack8(G[2], G[3]);
  {
    float* Y = dir ? p.yb : p.yf;
    const int i = 16 * w + lr;
    const int r = r0 + (dir ? 63 - i : i);
#pragma unroll
    for (int mp = 0; mp < 4; ++mp) {
      f32x4 y = (f32x4){0.f, 0.f, 0.f, 0.f};
#pragma unroll
      for (int kb = 0; kb < 2; ++kb) {
        u32x2 lo = *(const u32x2*)(sXT + (16 * mp + lr) * 144 + (kb * 32 + 4 * g) * 2);
        u32x2 hi = *(const u32x2*)(sXT + (16 * mp + lr) * 144 + (kb * 32 + 16 + 4 * g) * 2);
        u32x4 a; a[0] = lo[0]; a[1] = lo[1]; a[2] = hi[0]; a[3] = hi[1];
        y = mfma(__builtin_bit_cast(bf16x8, a), bM[kb], y);
      }
      *(f32x4*)(Y + (long)r * 256 + h * 64 + 16 * mp + 4 * g) = y;
    }
  }
  {
    bf16x8 bX[2];
#pragma unroll
    for (int ks = 0; ks < 2; ++ks) bX[ks] = *(const bf16x8*)(sXT + (16 * w + lr) * 144 + ks * 64 + g * 16);
#pragma unroll
    for (int mt = 0; mt < 8; ++mt) {
      f32x4 s = (f32x4){0.f, 0.f, 0.f, 0.f};
#pragma unroll
      for (int ks = 0; ks < 2; ++ks) {
        bf16x8 a = *(const bf16x8*)(sBT + (16 * mt + lr) * 144 + ks * 64 + g * 16);
        s = mfma(a, bX[ks], s);
      }
      u32x2 o; o[0] = pack2(s[0], s[1]); o[1] = pack2(s[2], s[3]);
      *(u32x2*)(p.pst + ob + (16 * w + lr) * 128 + 16 * mt + 4 * g) = o;
    }
  }
  __syncthreads();
}

__device__ __forceinline__ void dn_chain(const P& p, int l, int cidx, char* smem) {
  const int tid = get_tid(), lane = tid & 63, w = tid >> 6, g = lane >> 4, lr = lane & 15;
  const int dir = cidx & 1, h = (cidx >> 1) & 3, seq = cidx >> 3;
  int row0, L, krow0, Lk; long vtb;
  seq_info(seq, row0, L, krow0, Lk, vtb);
  const int n = L >> 6, cg0 = row0 >> 6;
  const int dvc = 16 * w + lr;
  constexpr int MSZ = 64 * 144, STG = 4 * MSZ;
  f32x4 S[4];
  if (seq >= 16) {
    const float* s0 = p.in[4] + ((((long)(seq - 16) * 4 + l) * 2 + dir) * 4 + h) * 4096;
#pragma unroll
    for (int mt = 0; mt < 4; ++mt)
#pragma unroll
      for (int j = 0; j < 4; ++j) S[mt][j] = s0[(16 * mt + 4 * g + j) * 64 + dvc];
  } else {
#pragma unroll
    for (int mt = 0; mt < 4; ++mt) S[mt] = (f32x4){0.f, 0.f, 0.f, 0.f};
  }
  bf16* O = dir ? p.ob : p.of;
  u32x4 rg[8]; u32x2 un[4]; float gln;
  auto item_of = [&](int c) __attribute__((always_inline)) { const int oc = dir ? n - 1 - c : c; return ((cg0 + oc) * 4 + h) * 2 + dir; };
  auto gload = [&](int item) __attribute__((always_inline)) {
    const long ob = (long)item * 4096;
#pragma unroll
    for (int i = 0; i < 8; ++i) {
      const int mat = i >> 1, rem = tid + 256 * (i & 1);
      const bf16* base = (mat == 0) ? p.pw : (mat == 1) ? p.pqd : (mat == 2) ? p.pqk : p.pkd;
      rg[i] = *(const u32x4*)(base + ob + rem * 8);
    }
#pragma unroll
    for (int mt = 0; mt < 4; ++mt) un[mt] = *(const u32x2*)(p.pu + ob + dvc * 64 + 16 * mt + 4 * g);
    gln = p.pgl[item];
  };
  auto sstore = [&](int st) __attribute__((always_inline)) {
#pragma unroll
    for (int i = 0; i < 8; ++i) {
      const int mat = i >> 1, rem = tid + 256 * (i & 1), row = rem >> 3, ch = rem & 7;
      *(u32x4*)(smem + st * STG + mat * MSZ + row * 144 + ch * 16) = rg[i];
    }
  };
  gload(item_of(0));
  sstore(0);
  __syncthreads();
  for (int c = 0; c < n; ++c) {
    const int oc = dir ? n - 1 - c : c;
    u32x2 uc[4];
#pragma unroll
    for (int mt = 0; mt < 4; ++mt) uc[mt] = un[mt];
    const float egl = __expf(gln);
    if (c + 1 < n) gload(item_of(c + 1));
    __builtin_amdgcn_sched_barrier(0);
    const char* sb = smem + (c & 1) * STG + lr * 144 + g * 16;
    bf16x8 bS[2];
    bS[0] = pack8(S[0], S[1]); bS[1] = pack8(S[2], S[3]);
    f32x4 vn[4], o[4];
#pragma unroll
    for (int mt = 0; mt < 4; ++mt) {
      f32x4 a = (f32x4){0.f, 0.f, 0.f, 0.f}, b = (f32x4){0.f, 0.f, 0.f, 0.f};
#pragma unroll
      for (int ks = 0; ks < 2; ++ks) {
        bf16x8 aw = *(const bf16x8*)(sb + 0 * MSZ + mt * 16 * 144 + ks * 64);
        bf16x8 aq = *(const bf16x8*)(sb + 1 * MSZ + mt * 16 * 144 + ks * 64);
        a = mfma(aw, bS[ks], a);
        b = mfma(aq, bS[ks], b);
      }
      vn[mt][0] = lo2f(uc[mt][0]) - a[0]; vn[mt][1] = hi2f(uc[mt][0]) - a[1];
      vn[mt][2] = lo2f(uc[mt][1]) - a[2]; vn[mt][3] = hi2f(uc[mt][1]) - a[3];
      o[mt] = b;
    }
    bf16x8 bV[2];
    bV[0] = pack8(vn[0], vn[1]); bV[1] = pack8(vn[2], vn[3]);
#pragma unroll
    for (int mt = 0; mt < 4; ++mt) {
      f32x4 sn;
#pragma unroll
      for (int j = 0; j < 4; ++j) sn[j] = S[mt][j] * egl;
#pragma unroll
      for (int kb = 0; kb < 2; ++kb) {
        bf16x8 aqk = *(const bf16x8*)(sb + 2 * MSZ + mt * 16 * 144 + kb * 64);
        bf16x8 akd = *(const bf16x8*)(sb + 3 * MSZ + mt * 16 * 144 + kb * 64);
        o[mt] = mfma(aqk, bV[kb], o[mt]);
        sn = mfma(akd, bV[kb], sn);
      }
      S[mt] = sn;
    }
#pragma unroll
    for (int mt = 0; mt < 4; ++mt)
#pragma unroll
      for (int j = 0; j < 4; ++j) {
        int i = 16 * mt + 4 * g + j;
        int r = (cg0 + oc) * 64 + (dir ? 63 - i : i);
        O[(long)r * 256 + h * 64 + dvc] = f2bf(o[mt][j]);
      }
    __builtin_amdgcn_sched_barrier(0);
    if (c + 1 < n) sstore((c + 1) & 1);
    __syncthreads();
  }
  if (seq < 16) {
    float* so = p.out + O_SD + ((((long)seq * 4 + l) * 2 + dir) * 4 + h) * 4096;
#pragma unroll
    for (int mt = 0; mt < 4; ++mt)
#pragma unroll
      for (int j = 0; j < 4; ++j) so[(16 * mt + 4 * g + j) * 64 + dvc] = S[mt][j];
  }
}

__device__ __forceinline__ void ssd_chain(const P& p, int l, int cidx, char* smem) {
  const int tid = get_tid(), lane = tid & 63, w = tid >> 6, g = lane >> 4, lr = lane & 15;
  const int dir = cidx & 1, h = (cidx >> 1) & 3, seq = cidx >> 3;
  int row0, L, krow0, Lk; long vtb;
  seq_info(seq, row0, L, krow0, Lk, vtb);
  const int n = L >> 6, cg0 = row0 >> 6;
  const int pc = 16 * w + lr;
  constexpr int STG = 64 * 272;
  f32x4 S[8];
  if (seq >= 16) {
    const float* s0 = p.in[7] + ((((long)(seq - 16) * 4 + l) * 2 + dir) * 4 + h) * 8192;
#pragma unroll
    for (int mt = 0; mt < 8; ++mt) S[mt] = *(const f32x4*)(s0 + pc * 128 + 16 * mt + 4 * g);
  } else {
#pragma unroll
    for (int mt = 0; mt < 8; ++mt) S[mt] = (f32x4){0.f, 0.f, 0.f, 0.f};
  }
  float* Y = dir ? p.yb : p.yf;
  u32x4 rg[4]; u32x2 stn[8]; float yn[16]; float lastn;
  auto item_of = [&](int c) __attribute__((always_inline)) { const int oc = dir ? n - 1 - c : c; return ((cg0 + oc) * 4 + h) * 2 + dir; };
  auto gload = [&](int c) __attribute__((always_inline)) {
    const int oc = dir ? n - 1 - c : c;
    const int item = ((cg0 + oc) * 4 + h) * 2 + dir;
    const long ob = (long)item * 8192;
#pragma unroll
    for (int i = 0; i < 4; ++i) rg[i] = *(const u32x4*)(p.pcd + ob + (tid + 256 * i) * 8);
#pragma unroll
    for (int mt = 0; mt < 8; ++mt) stn[mt] = *(const u32x2*)(p.pst + ob + pc * 128 + 16 * mt + 4 * g);
#pragma unroll
    for (int mt = 0; mt < 4; ++mt)
#pragma unroll
      for (int j = 0; j < 4; ++j) {
        int i = 16 * mt + 4 * g + j;
        int r = (cg0 + oc) * 64 + (dir ? 63 - i : i);
        yn[mt * 4 + j] = Y[(long)r * 256 + h * 64 + pc];
      }
    lastn = p.plast[item];
  };
  auto sstore = [&](int st) __attribute__((always_inline)) {
#pragma unroll
    for (int i = 0; i < 4; ++i) {
      const int id = tid + 256 * i, row = id >> 4, ch = id & 15;
      *(u32x4*)(smem + st * STG + row * 272 + ch * 16) = rg[i];
    }
  };
  gload(0);
  sstore(0);
  __syncthreads();
  for (int c = 0; c < n; ++c) {
    const int oc = dir ? n - 1 - c : c;
    u32x2 stc[8]; float yc[16];
#pragma unroll
    for (int mt = 0; mt < 8; ++mt) stc[mt] = stn[mt];
#pragma unroll
    for (int q = 0; q < 16; ++q) yc[q] = yn[q];
    const float el = __expf(lastn);
    if (c + 1 < n) gload(c + 1);
    __builtin_amdgcn_sched_barrier(0);
    const char* sb = smem + (c & 1) * STG + lr * 272 + g * 16;
    bf16x8 bS[4];
#pragma unroll
    for (int ks = 0; ks < 4; ++ks) bS[ks] = pack8(S[2 * ks], S[2 * ks + 1]);
#pragma unroll
    for (int mt = 0; mt < 4; ++mt) {
      f32x4 y = (f32x4){0.f, 0.f, 0.f, 0.f};
#pragma unroll
      for (int ks = 0; ks < 4; ++ks) {
        bf16x8 a = *(const bf16x8*)(sb + mt * 16 * 272 + ks * 64);
        y = mfma(a, bS[ks], y);
      }
#pragma unroll
      for (int j = 0; j < 4; ++j) {
        int i = 16 * mt + 4 * g + j;
        int r = (cg0 + oc) * 64 + (dir ? 63 - i : i);
        Y[(long)r * 256 + h * 64 + pc] = yc[mt * 4 + j] + y[j];
      }
    }
#pragma unroll
    for (int mt = 0; mt < 8; ++mt) {
      S[mt][0] = S[mt][0] * el + lo2f(stc[mt][0]); S[mt][1] = S[mt][1] * el + hi2f(stc[mt][0]);
      S[mt][2] = S[mt][2] * el + lo2f(stc[mt][1]); S[mt][3] = S[mt][3] * el + hi2f(stc[mt][1]);
    }
    __builtin_amdgcn_sched_barrier(0);
    if (c + 1 < n) sstore((c + 1) & 1);
    __syncthreads();
  }
  if (seq < 16) {
    float* so = p.out + O_SS + ((((long)seq * 4 + l) * 2 + dir) * 4 + h) * 8192;
#pragma unroll
    for (int mt = 0; mt < 8; ++mt) *(f32x4*)(so + pc * 128 + 16 * mt + 4 * g) = S[mt];
  }
}

template <bool MLA, int NQ>
__device__ __forceinline__ void attn_item(const P& p, int l, int seq, int h, int qb, int sub, char* smem) {
  constexpr int KS = MLA ? 3 : 1;
  constexpr int KSTR = MLA ? 208 : 80;
  constexpr int NKC = MLA ? 3 : 1;
  constexpr int KCH = MLA ? 12 : 4;
  constexpr int BUF = 64 * KSTR + 64 * 144;
  const int tid = get_tid(), lane = tid & 63, w = tid >> 6, g = lane >> 4, lr = lane & 15;
  int row0, L, krow0, Lk; long vtbase;
  seq_info(seq, row0, L, krow0, Lk, vtbase);
  const int r0 = row0 + qb * (NQ * 64) + w * (NQ * 16);
  const int nkt = Lk >> 6;
  const bf16* vt = (MLA ? p.vtm : p.vtd) + vtbase + (long)h * 64 * Lk;
  bf16x8 bq[KS][NQ];
#pragma unroll
  for (int nt = 0; nt < NQ; ++nt) {
    const int r = r0 + nt * 16 + lr;
    if (MLA) {
      const float sc = 0.10206207261596577f * LOG2E;
#pragma unroll
      for (int ks = 0; ks < KS; ++ks) {
        u32x4 v = *(const u32x4*)(p.qm + (long)r * 384 + h * 96 + ks * 32 + g * 8);
        u32x4 o;
#pragma unroll
        for (int q = 0; q < 4; ++q) o[q] = pack2(lo2f(v[q]) * sc, hi2f(v[q]) * sc);
        bq[ks][nt] = __builtin_bit_cast(bf16x8, o);
      }
    } else {
      bq[0][nt] = *(const bf16x8*)(p.qd + (long)r * 256 + h * 64 + sub * 32 + g * 8);
    }
  }
  f32x4 O[4][NQ];
  float mx[NQ], ls[NQ];
#pragma unroll
  for (int nt = 0; nt < NQ; ++nt) {
    mx[nt] = 0.f; ls[nt] = 0.f;
#pragma unroll
    for (int mv = 0; mv < 4; ++mv) O[mv][nt] = (f32x4){0.f, 0.f, 0.f, 0.f};
  }
  u32x4 kreg0[NKC], vreg0[2], kreg1[NKC], vreg1[2];
  auto load_tile = [&](int kt, u32x4 (&kreg)[NKC], u32x4 (&vreg)[2]) __attribute__((always_inline)) {
#pragma unroll
    for (int i = 0; i < NKC; ++i) {
      int id = tid + 256 * i, key = id / KCH, ch = id % KCH;
      long kr = krow0 + kt * 64 + key;
      if (MLA) {
        if (ch < 8) kreg[i] = *(const u32x4*)(p.knope + kr * 256 + h * 64 + ch * 8);
        else kreg[i] = *(const u32x4*)(p.kr + kr * 32 + (ch - 8) * 8);
      } else kreg[i] = *(const u32x4*)(p.kd + kr * 256 + h * 64 + sub * 32 + ch * 8);
    }
#pragma unroll
    for (int i = 0; i < 2; ++i) {
      int id = tid + 256 * i, v = id >> 3, ch = id & 7;
      vreg[i] = *(const u32x4*)(vt + (long)v * Lk + kt * 64 + ch * 8);
    }
  };
  auto store_tile = [&](int b, const u32x4 (&kreg)[NKC], const u32x4 (&vreg)[2]) __attribute__((always_inline)) {
    char* sK = smem + b * BUF; char* sV = sK + 64 * KSTR;
#pragma unroll
    for (int i = 0; i < NKC; ++i) {
      int id = tid + 256 * i, key = id / KCH, ch = id % KCH;
      *(u32x4*)(sK + key * KSTR + ch * 16) = kreg[i];
    }
#pragma unroll
    for (int i = 0; i < 2; ++i) {
      int id = tid + 256 * i, v = id >> 3, ch = id & 7;
      int blk = (ch >> 2) * 32, u0 = 2 * (ch & 3), u1 = u0 + 1;
      int p0 = (u0 < 4) ? 2 * u0 : 2 * (u0 - 4) + 1, p1 = (u1 < 4) ? 2 * u1 : 2 * (u1 - 4) + 1;
      u32x2 a, bb; a[0] = vreg[i][0]; a[1] = vreg[i][1]; bb[0] = vreg[i][2]; bb[1] = vreg[i][3];
      *(u32x2*)(sV + v * 144 + (blk + p0 * 4) * 2) = a;
      *(u32x2*)(sV + v * 144 + (blk + p1 * 4) * 2) = bb;
    }
  };
  auto compute = [&](int cur) __attribute__((always_inline)) {
    const char* sK = smem + cur * BUF; const char* sV = sK + 64 * KSTR;
    f32x4 s[4][NQ];
#pragma unroll
    for (int mt = 0; mt < 4; ++mt) {
#pragma unroll
      for (int nt = 0; nt < NQ; ++nt) s[mt][nt] = (f32x4){-mx[nt], -mx[nt], -mx[nt], -mx[nt]};
#pragma unroll
      for (int ks = 0; ks < KS; ++ks) {
        bf16x8 aK = *(const bf16x8*)(sK + (mt * 16 + lr) * KSTR + ks * 64 + g * 16);
#pragma unroll
        for (int nt = 0; nt < NQ; ++nt) s[mt][nt] = mfma(aK, bq[ks][nt], s[mt][nt]);
      }
    }
    float tm[NQ];
#pragma unroll
    for (int nt = 0; nt < NQ; ++nt) {
      float t0 = fmaxf(fmaxf(s[0][nt][0], s[0][nt][1]), fmaxf(s[0][nt][2], s[0][nt][3]));
#pragma unroll
      for (int mt = 1; mt < 4; ++mt) t0 = fmaxf(t0, fmaxf(fmaxf(s[mt][nt][0], s[mt][nt][1]), fmaxf(s[mt][nt][2], s[mt][nt][3])));
      t0 = fmaxf(t0, __shfl_xor(t0, 16));
      t0 = fmaxf(t0, __shfl_xor(t0, 32));
      tm[nt] = t0;
    }
    if (__any((tm[0] > 8.f) || (tm[NQ - 1] > 8.f))) {
#pragma unroll
      for (int nt = 0; nt < NQ; ++nt) {
        const float d = fmaxf(tm[nt], 0.f);
        const float al = ex2(-d);
        mx[nt] += d; ls[nt] *= al;
#pragma unroll
        for (int mv = 0; mv < 4; ++mv)
#pragma unroll
          for (int j = 0; j < 4; ++j) O[mv][nt][j] *= al;
#pragma unroll
        for (int mt = 0; mt < 4; ++mt)
#pragma unroll
          for (int j = 0; j < 4; ++j) s[mt][nt][j] -= d;
      }
    }
    bf16x8 bP[2][NQ];
#pragma unroll
    for (int nt = 0; nt < NQ; ++nt) {
      float su = 0.f;
#pragma unroll
      for (int mt = 0; mt < 4; ++mt)
#pragma unroll
        for (int j = 0; j < 4; ++j) { float e = ex2(s[mt][nt][j]); s[mt][nt][j] = e; su += e; }
      ls[nt] += su;
      bP[0][nt] = pack8(s[0][nt], s[1][nt]);
      bP[1][nt] = pack8(s[2][nt], s[3][nt]);
    }
#pragma unroll
    for (int mv = 0; mv < 4; ++mv)
#pragma unroll
      for (int kb = 0; kb < 2; ++kb) {
        bf16x8 aV = *(const bf16x8*)(sV + (mv * 16 + lr) * 144 + kb * 64 + g * 16);
#pragma unroll
        for (int nt = 0; nt < NQ; ++nt) O[mv][nt] = mfma(aV, bP[kb][nt], O[mv][nt]);
      }
  };
  load_tile(0, kreg0, vreg0);
  load_tile(1, kreg1, vreg1);
  store_tile(0, kreg0, vreg0);
  __syncthreads();
  for (int kt = 0; kt < nkt; kt += 2) {
    load_tile(min(kt + 2, nkt - 1), kreg0, vreg0);
    __builtin_amdgcn_sched_barrier(0);
    compute(0);
    __builtin_amdgcn_sched_barrier(0);
    store_tile(1, kreg1, vreg1);
    __syncthreads();
    load_tile(min(kt + 3, nkt - 1), kreg1, vreg1);
    __builtin_amdgcn_sched_barrier(0);
    compute(1);
    __builtin_amdgcn_sched_barrier(0);
    store_tile(0, kreg0, vreg0);
    __syncthreads();
  }
#pragma unroll
  for (int nt = 0; nt < NQ; ++nt) {
    const int r = r0 + nt * 16 + lr;
    float sm = ls[nt];
    sm += __shfl_xor(sm, 16); sm += __shfl_xor(sm, 32);
    const float inv = 1.f / sm;
    if (MLA) {
#pragma unroll
      for (int mv = 0; mv < 4; ++mv) {
        u32x2 o; o[0] = pack2(O[mv][nt][0] * inv, O[mv][nt][1] * inv);
        o[1] = pack2(O[mv][nt][2] * inv, O[mv][nt][3] * inv);
        *(u32x2*)(p.hbf + (long)r * LDH + 512 + h * 64 + mv * 16 + 4 * g) = o;
      }
    } else {
#pragma unroll
      for (int mv = 0; mv < 4; ++mv) {
        u32x2 o; o[0] = pack2(O[mv][nt][0] * inv, O[mv][nt][1] * inv); o[1] = pack2(O[mv][nt][2] * inv, O[mv][nt][3] * inv);
        *(u32x2*)(p.ao + ((long)sub * NTOK + r) * 256 + h * 64 + mv * 16 + 4 * g) = o;
      }
    }
  }
}

#define P4_ITEMS 1696
__device__ __forceinline__ void p4_item(const P& p, int l, int it, char* smem, int skip_ssd) {
  int kind, a0 = 0, a1 = 0, a2 = 0, a3 = 0;
  if (it < 16) { kind = 0; a0 = 128 + it; }
  else if (it < 32) { kind = 1; a0 = 128 + it - 16; }
  else if (it < 288) { int q = it - 32; kind = 3; a0 = 16 + (q >> 7); a1 = (q >> 5) & 3; a2 = q & 31; }
  else if (it < 544) { int q = it - 288; kind = 2; a3 = q & 1; q >>= 1; a0 = 16 + (q >> 7); a1 = (q >> 5) & 3; a2 = q & 31; }
  else if (it < 1056) { int u = it - 544; int q = 256 + (u >> 1); kind = 4; a3 = q & 1; q >>= 1; a0 = 16 + (q >> 7); a1 = (q >> 5) & 3; a2 = (q & 31) * 2 + (u & 1); }
  else if (it < 1184) { kind = 0; a0 = it - 1056; }
  else if (it < 1312) { kind = 1; a0 = it - 1184; }
  else if (it < 1440) { int q = it - 1312; kind = 3; a0 = q >> 3; a1 = (q >> 1) & 3; a2 = q & 1; }
  else { int q = it - 1440; kind = 2; a3 = q & 1; q >>= 1; a0 = q >> 3; a1 = (q >> 1) & 3; a2 = q & 1; }
  if (kind == 0) dn_chain(p, l, a0, smem);
  else if (kind == 1) { if (!skip_ssd) ssd_chain(p, l, a0, smem); }
  else if (kind == 2) attn_item<false, 2>(p, l, a0, a1, a2, a3, smem);
  else if (kind == 3) attn_item<true, 2>(p, l, a0, a1, a2, 0, smem);
  else attn_item<false, 1>(p, l, a0, a1, a2, a3, smem);
}

__device__ __forceinline__ void finalize_rows(const P& p, int l, int item) {
  const int tid_ = get_tid(); const int lane = tid_ & 63, w = tid_ >> 6;
  const int r = item * 4 + w;
  const bf16* pr = p.proj + (long)r * NPROJ;
  const int c = lane * 4;
  {
    const float* lp = p.in[13] + l * 128;
    float d0 = 0.f, d1 = 0.f;
    for (int i = 0; i < 32; ++i) { d0 += lp[i] * lp[32 + i]; d1 += lp[64 + i] * lp[96 + i]; }
    const float lam_init = 0.8f - 0.6f * expf(-0.3f * (float)l);
    const float lam = expf(d0) - expf(d1) + lam_init;
    const u32x2 ua = *(const u32x2*)(p.ao + (long)r * 256 + c), ub = *(const u32x2*)(p.ao + ((long)NTOK + r) * 256 + c);
    const f32x4 a = (f32x4){lo2f(ua[0]), hi2f(ua[0]), lo2f(ua[1]), hi2f(ua[1])}, b = (f32x4){lo2f(ub[0]), hi2f(ub[0]), lo2f(ub[1]), hi2f(ub[1])};
    float o[4], ss = 0.f;
#pragma unroll
    for (int j = 0; j < 4; ++j) { o[j] = a[j] - lam * b[j]; ss += o[j] * o[j]; }
    ss += __shfl_xor(ss, 1); ss += __shfl_xor(ss, 2); ss += __shfl_xor(ss, 4); ss += __shfl_xor(ss, 8);
    float rs = rsqrtf(ss * (1.f / 64.f) + EPS_F) * (1.f - lam_init);
    f32x4 gn = *(const f32x4*)(p.in[14] + l * 64 + (c & 63));
    u32x2 out;
    out[0] = pack2(o[0] * rs * gn[0], o[1] * rs * gn[1]);
    out[1] = pack2(o[2] * rs * gn[2], o[3] * rs * gn[3]);
    *(u32x2*)(p.hbf + (long)r * LDH + c) = out;
  }
  {
    const u32x2 ua = *(const u32x2*)(p.of + (long)r * 256 + c), ub = *(const u32x2*)(p.ob + (long)r * 256 + c);
    const f32x4 a = (f32x4){lo2f(ua[0]), hi2f(ua[0]), lo2f(ua[1]), hi2f(ua[1])}, b = (f32x4){lo2f(ub[0]), hi2f(ub[0]), lo2f(ub[1]), hi2f(ub[1])};
    float o[4], ss = 0.f;
#pragma unroll
    for (int j = 0; j < 4; ++j) { o[j] = a[j] + b[j]; ss += o[j] * o[j]; }
    ss += __shfl_xor(ss, 1); ss += __shfl_xor(ss, 2); ss += __shfl_xor(ss, 4); ss += __shfl_xor(ss, 8);
    float rs = rsqrtf(ss * (1.f / 64.f) + EPS_F);
    f32x4 gn = *(const f32x4*)(p.in[18] + l * 64 + (c & 63));
    u32x2 gt = *(const u32x2*)(pr + C_BGATE + c);
    float gv[4] = {lo2f(gt[0]), hi2f(gt[0]), lo2f(gt[1]), hi2f(gt[1])};
    u32x2 out;
    out[0] = pack2(o[0] * rs * gn[0] * siluf(gv[0]), o[1] * rs * gn[1] * siluf(gv[1]));
    out[1] = pack2(o[2] * rs * gn[2] * siluf(gv[2]), o[3] * rs * gn[3] * siluf(gv[3]));
    *(u32x2*)(p.hbf + (long)r * LDH + 256 + c) = out;
  }
  {
    f32x4 a = *(const f32x4*)(p.yf + (long)r * 256 + c), b = *(const f32x4*)(p.yb + (long)r * 256 + c);
    u32x2 xx = *(const u32x2*)(p.sx + (long)r * 256 + c);
    u32x2 zz = *(const u32x2*)(pr + C_DZ + c);
    float xv[4] = {lo2f(xx[0]), hi2f(xx[0]), lo2f(xx[1]), hi2f(xx[1])};
    float zv[4] = {lo2f(zz[0]), hi2f(zz[0]), lo2f(zz[1]), hi2f(zz[1])};
    float dsk = p.in[28][l * 4 + (lane >> 4)];
    float y[4], ss = 0.f;
#pragma unroll
    for (int j = 0; j < 4; ++j) { y[j] = (a[j] + b[j] + dsk * xv[j]) * siluf(zv[j]); ss += y[j] * y[j]; }
    ss += __shfl_xor(ss, 1); ss += __shfl_xor(ss, 2); ss += __shfl_xor(ss, 4); ss += __shfl_xor(ss, 8); ss += __shfl_xor(ss, 16);
    float rs = rsqrtf(ss * (1.f / 128.f) + EPS_F);
    f32x4 gn = *(const f32x4*)(p.in[29] + l * 256 + c);
    u32x2 out;
    out[0] = pack2(y[0] * rs * gn[0], y[1] * rs * gn[1]);
    out[1] = pack2(y[2] * rs * gn[2], y[3] * rs * gn[3]);
    *(u32x2*)(p.hbf + (long)r * LDH + 768 + c) = out;
  }
}

struct EpiProj {
  static constexpr bool STAGED = true;
  bf16* dst; int ld;
  __device__ __forceinline__ f32x4 transform(int r, int c, f32x4 v) const { return v; }
};
struct EpiRes {
  static constexpr bool STAGED = true;
  bf16* dst; int ld;
  const bf16* xb; const float* mod; int gate_idx; int l;
  __device__ __forceinline__ f32x4 transform(int r, int c, f32x4 v) const {
    const int modi = (r < NPROMPT) ? 0 : 1 + ((r - NPROMPT) >> 12);
    const float gt = mod[((long)l * 3 + modi) * 6144 + gate_idx * 1024 + c];
#pragma unroll
    for (int j = 0; j < 4; ++j) v[j] = ALPHA_F * bf2f(xb[(long)(r + j) * 2048 + c]) + gt * v[j];
    return v;
  }
};
struct EpiAct {
  static constexpr bool STAGED = true;
  bf16* dst; int ld;
  __device__ __forceinline__ f32x4 transform(int r, int c, f32x4 v) const {
#pragma unroll
    for (int j = 0; j < 4; ++j) { float x = fmaxf(v[j], 0.f); v[j] = x * x; }
    return v;
  }
};
struct EpiUq {
  static constexpr bool STAGED = true;
  bf16* dst; int ld;
  const P* p;
  __device__ __forceinline__ f32x4 transform(int r, int c, f32x4 v) const {
    const int cc = c % 96;
    const bool ropecol = cc >= 64;
    const int d = (cc - 64) & 31;
    const float sg = ((d >> 3) & 1) ? 1.f : -1.f;
#pragma unroll
    for (int j = 0; j < 4; ++j) {
      float x = v[j];
      float xp = __shfl_xor(x, 8);
      const int rr = r + j;
      if (ropecol && rr >= NPROMPT) {
        float cs, sn; rope_cs(*p, (rr - NPROMPT) & 4095, d, cs, sn);
        x = x * cs + sg * xp * sn;
      }
      v[j] = x;
    }
    return v;
  }
};
struct EpiUkv {
  static constexpr bool STAGED = false;
  const P* p;
  __device__ __forceinline__ void operator()(int r, int c, f32x4 v) const {
    if (c < 256) {
#pragma unroll
      for (int j = 0; j < 4; ++j) p->knope[(long)(r + j) * 256 + c] = f2bf(v[j]);
    } else {
      long base; int key, Lk;
      if (r < NPROMPT) { base = (long)(r >> 8) * 65536; key = r & 255; Lk = 256; }
      else { int rr = r - NPROMPT; int b = rr / 4352; key = rr - b * 4352; Lk = 4352; base = 1048576L + (long)b * (256L * 4352L); }
      u32x2 o; o[0] = pack2(v[0], v[1]); o[1] = pack2(v[2], v[3]);
      *(u32x2*)(p->vtm + base + (long)(c - 256) * Lk + key) = o;
    }
  }
};

__device__ __forceinline__ void xcd_local_barrier(const P& p, const Sched& sc, unsigned* cnt) {
  asm volatile("s_waitcnt vmcnt(0)" ::: "memory");
  __syncthreads();
  if (threadIdx.x == 0) {
    xb_add(cnt, 1u);
    XB_SPIN(xb_ld(cnt) < (unsigned)sc.nloc, p.bar);
  }
  __syncthreads();
}
__device__ __forceinline__ void xcd_ln_then_sync(const P& p, const Sched& sc, int mode, const float* lg, const float* lb, int l,
                                                  int shift_idx, int scale_idx, unsigned* cnt) {
  const int base = sc.xcc * 12 * 16;
  for (int t = sc.rank; t < 192; t += sc.nloc) lnmod_rows(p, base + t, mode, lg, lb, l, shift_idx, scale_idx);
  asm volatile("s_waitcnt vmcnt(0)" ::: "memory");
  __syncthreads();
  if (threadIdx.x == 0) {
    xb_add(cnt, 1u);
    XB_SPIN(xb_ld(cnt) < (unsigned)sc.nloc, p.bar);
  }
  __syncthreads();
}

#define NPHASE 42
__device__ __forceinline__ void run_phase(const P& p, int ph, char* smem, const Sched& sc, int skip_ssd = 0) {
  const int bid = blockIdx.x, nb = gridDim.x;
  if (ph == 0) {
    for (int t = bid; t < 193 + 872; t += nb) {
      if (t < 193) pre_item(p, t, smem);
      else { const int q = t - 193; wconv_item(p, 0, q < WC_IN ? q : q + (WC_OUT + WC_FF1 + WC_FF2), smem); }
    }
    return;
  }
  if (ph == 41) {
    for (int t = bid; t < NTOK / 8; t += nb) lnmod_rows(p, t, 2, p.in[33] + 3 * DM, p.in[34] + 3 * DM, 3, 0, 0);
    return;
  }
  const int l = (ph - 1) / 10, s = (ph - 1) % 10;
  switch (s) {
    case 0: {
      for (int t = bid; t < NTOK / 8; t += nb) {
        if (l == 0) lnmod_rows(p, t, 0, nullptr, nullptr, l, 0, 1);
        else lnmod_rows(p, t, 1, p.in[33] + (l - 1) * DM, p.in[34] + (l - 1) * DM, l, 0, 1);
      }
    } break;
    case 1: {
      EpiProj e{p.proj, NPROJ};
      int mt, nt;
      if (sc.ok) {
        unsigned* cnt = p.bar + XCD_BAR_WORDS + 4096 + ((l * 2 + 0) * 8 + sc.xcc) * 64;
        if (l == 0) xcd_ln_then_sync(p, sc, 0, nullptr, nullptr, l, 0, 1, cnt);
        else xcd_ln_then_sync(p, sc, 1, p.in[33] + (l - 1) * DM, p.in[34] + (l - 1) * DM, l, 0, 1, cnt);
      }
      for (int it = 0; sched_tile(sc, 96, 26, 8, it, mt, nt); ++it) gemm_tile(p.hbf, LDH, p.winT, LDH, DM, mt * 128, nt * 128, smem, e);
      {
        int k = -1;
        if (sc.ok && sc.nloc == 64) { if (sc.rank >= 56 && sc.rank < 60) k = sc.xcc * 4 + (sc.rank - 56); }
        else if (bid < 2 * NT_PAST) k = bid;
        if (k >= 0) { if (k < NT_PAST) prep_diff(p, l, NT_OWN + k); else prep_mla(p, l, NT_OWN + k - NT_PAST); }
      }
    } break;
    case 2: {
      for (int t = bid; t < 4 * NT_OWN; t += nb) {
        if (t < NT_OWN) prep_dn(p, l, t);
        else if (t < 2 * NT_OWN) prep_ssd(p, l, t - NT_OWN);
        else if (t < 3 * NT_OWN) prep_diff(p, l, t - 2 * NT_OWN);
        else prep_mla(p, l, t - 3 * NT_OWN);
      }
    } break;
    case 3: {
      EpiUq eq{p.qm, 384, &p}; EpiUkv ek{&p};
      for (int t = bid; t < 1536 + 1536 + 288 + 400; t += nb) {
        if (t < 1536) dn_chunk_prep(p, t, smem);
        else if (t < 3072) ssd_chunk_prep(p, l, t - 1536, smem);
        else if (t < 3360) { int q = t - 3072; gemm_tile(p.cqn, LDQ, p.wuqT, LDQ, 256, (q / 3) * 128, (q % 3) * 128, smem, eq); }
        else { int q = t - 3360; gemm_tile(p.ckv, LDC, p.wukvT, LDC, 128, (q / 4) * 128, (q % 4) * 128, smem, ek); }
      }
    } break;
    case 4: {
      unsigned* cnt = p.bar + XCD_BAR_WORDS + 1024 + l * 64;
      for (;;) {
        __syncthreads();
        if (threadIdx.x == 0) sc.st[3] = xb_add(cnt, 1u);
        __syncthreads();
        const int it = (int)sc.st[3];
        const int nwc = (l == 0) ? (WC_OUT + WC_FF1) : 0;
        if (it >= P4_ITEMS + nwc) break;
        if (it < P4_ITEMS) p4_item(p, l, it, smem, skip_ssd);
        else wconv_item(p, l, WC_IN + (it - P4_ITEMS), smem);
      }
    } break;
    case 5: {
      if (sc.ok) { for (int t = sc.rank; t < 384; t += sc.nloc) finalize_rows(p, l, sc.xcc * 384 + t); }
      else for (int t = bid; t < NTOK / 4; t += nb) finalize_rows(p, l, t);
    } break;
    case 6: {
      EpiRes e{(bf16*)p.out + 1024, 2048, (const bf16*)p.out, p.mod, 2, l};
      int mt, nt;
      for (int it = 0; sched_tile(sc, 96, 8, 8, it, mt, nt); ++it) gemm_tile(p.hbf, LDH, p.woutT, LDH, DM, mt * 128, nt * 128, smem, e);
      {
        unsigned* cnt = p.bar + XCD_BAR_WORDS + 1024 + 512 + l * 64;
        for (;;) {
          __syncthreads();
          if (threadIdx.x == 0) sc.st[3] = xb_add(cnt, 1u);
          __syncthreads();
          const int q = (int)sc.st[3];
          if (q >= WC_FF2) break;
          wconv_item(p, l, WC_IN + WC_OUT + WC_FF1 + q, smem);
        }
      }
    } break;
    case 7: {
      for (int t = bid; t < NTOK / 8; t += nb) lnmod_rows(p, t, 1, p.in[31] + l * DM, p.in[32] + l * DM, l, 3, 4);
    } break;
    case 8: {
      EpiAct e{p.act, LDACT};
      int mt, nt;
      if (sc.ok) {
        unsigned* cnt = p.bar + XCD_BAR_WORDS + 4096 + ((l * 2 + 1) * 8 + sc.xcc) * 64;
        xcd_ln_then_sync(p, sc, 1, p.in[31] + l * DM, p.in[32] + l * DM, l, 3, 4, cnt);
      }
      for (int it = 0; sched_tile(sc, 96, 32, 8, it, mt, nt); ++it) gemm_tile(p.hbf, LDH, p.wff1T, LDH, DM, mt * 128, nt * 128, smem, e);
    } break;
    case 9: {
      EpiRes e{(bf16*)p.out + 1024, 2048, (const bf16*)p.out, p.mod, 5, l};
      int mt, nt;
      for (int it = 0; sched_tile(sc, 96, 8, 8, it, mt, nt); ++it) gemm_tile(p.act, LDACT, p.wff2T, LDACT, DFF, mt * 128, nt * 128, smem, e);
      if (l < 3) {
        unsigned* cnt = p.bar + XCD_BAR_WORDS + 1024 + 256 + l * 64;
        for (;;) {
          __syncthreads();
          if (threadIdx.x == 0) sc.st[3] = xb_add(cnt, 1u);
          __syncthreads();
          const int q = (int)sc.st[3];
          if (q >= 872 + WC_OUT + WC_FF1) break;
          if (q < 872) wconv_item(p, l + 1, q < WC_IN ? q : q + (WC_OUT + WC_FF1 + WC_FF2), smem);
          else wconv_item(p, l + 1, WC_IN + (q - 872), smem);
        }
      }
    } break;
  }
}

__global__ void __launch_bounds__(NTHR, 2) mega(P p, int ph_lo, int ph_hi, int coop) {
  __shared__ __attribute__((aligned(16))) char smem[SMEM_BYTES];
  __shared__ uint4 xb_words;
  if (threadIdx.x == 0) xb_words = make_uint4(0u, 0u, 0u, 0u);
  __syncthreads();
  XcdBarrier xb;
  xb.bar = p.bar; xb.x = 0; xb.st = (volatile LAS unsigned*)&xb_words;
  Sched sc; sc.xcc = 0; sc.rank = 0; sc.nloc = 1; sc.ok = 0; sc.st = (volatile LAS unsigned*)&xb_words;
  if (coop) {
    xb = xcd_barrier_post(p.bar, (volatile LAS unsigned*)&xb_words);
    if (threadIdx.x == 0) xb_words.z = xb_add(&p.bar[XCD_BAR_WORDS + 64 * xb.x], 1u);
    __syncthreads();
    sc.xcc = (int)xb.x; sc.rank = (int)((volatile LAS unsigned*)&xb_words)[2];
  }
  if (ph_hi > 1000) cg::this_grid().sync();
#define GRID_SYNC() xcd_barrier(xb)
  for (int ph = ph_lo; ph < ph_hi; ++ph) {
    if (coop && ph > ph_lo) {
      const unsigned nl = ((volatile LAS unsigned*)&xb_words)[0], nxx = ((volatile LAS unsigned*)&xb_words)[1];
      if (ph == ph_lo + 1) {
        unsigned hi = 0u;
#pragma unroll
        for (int j = 8; j < 16; ++j) hi |= xb_ld(&p.bar[XB_XCNT(j)]);
        sc.ok = (nxx == 8u && hi == 0u && nl > 0u) ? 1 : 0;
      }
      sc.nloc = (int)nl;
    }
    if (sc.ok && ph >= 1 && ph <= 40 && (((ph - 1) % 10) == 0 || ((ph - 1) % 10) == 7)) continue;
    run_phase(p, ph, smem, sc);
    if (coop && ph + 1 < ph_hi) {
      const int sph = (ph >= 1 && ph <= 40) ? (ph - 1) % 10 : -1;
      if (sc.ok && (sph == 5 || sph == 6)) xcd_local_barrier(p, sc, p.bar + XCD_BAR_WORDS + 8192 + ((((ph - 1) / 10) * 2 + (sph - 5)) * 8 + sc.xcc) * 64);
      else GRID_SYNC();
    }
#if (PROBE_MASK >> 10) & 1
    GRID_SYNC(); GRID_SYNC();
#endif
#if PROBE_MASK
    if (ph >= 1 && ph <= 40) {
      const int s = (ph - 1) % 10;
      if (((PROBE_MASK >> s) & 1) && s != 4) { run_phase(p, ph, smem, sc); GRID_SYNC(); }
    }
#endif
  }
}

static size_t align_up(size_t x) { return (x + 255) & ~(size_t)255; }

extern "C" void kernel_launch(void* const* d_in, const int* in_sizes, int n_in, void* d_out, int out_size, void* d_ws,
                              size_t ws_size, hipStream_t stream) {
  static int grid_blocks = 0;
  if (!grid_blocks) {
    int dev = 0, cus = 0, per_cu = 0;
    hipGetDevice(&dev);
    hipDeviceGetAttribute(&cus, hipDeviceAttributeMultiprocessorCount, dev);
    hipOccupancyMaxActiveBlocksPerMultiprocessor(&per_cu, mega, NTHR, 0);
    if (per_cu < 1) per_cu = 1;
    if (per_cu > 2) per_cu = 2;
    grid_blocks = cus * per_cu;
  }
  P p;
  memset(&p, 0, sizeof(p));
  for (int i = 0; i < 37; ++i) p.in[i] = (const float*)d_in[i];
  p.out = (float*)d_out;
  char* ws = (char*)d_ws;
  size_t off = 0;
  auto take = [&](size_t bytes) { char* q = ws + off; off = align_up(off + bytes); return q; };
  p.winT = (bf16*)take((size_t)NPROJ * LDH * 2);
  p.woutT = (bf16*)take((size_t)1024 * LDH * 2);
  p.wff1T = (bf16*)take((size_t)4096 * LDH * 2);
  p.wff2T = (bf16*)take((size_t)1024 * LDACT * 2);
  p.wuqT = (bf16*)take((size_t)384 * LDQ * 2);
  p.wukvT = (bf16*)take((size_t)512 * LDC * 2);
  p.mod = (float*)take((size_t)4 * 3 * 6144 * 4);
  p.ropeC = (float*)take(512 * 4);
  p.ropeS = (float*)take(512 * 4);
  p.hbf = (bf16*)take((size_t)NTOK * LDH * 2);
  size_t r1 = off;
  p.proj = (bf16*)take((size_t)NTOK * NPROJ * 2);
  p.qd = (bf16*)take((size_t)NTOK * 256 * 2);
  p.kd = (bf16*)take((size_t)NKROW * 256 * 2);
  p.vtd = (bf16*)take((size_t)3276800 * 2);
  p.cqn = (bf16*)take((size_t)NTOK * LDQ * 2);
  p.qm = (bf16*)take((size_t)NTOK * 384 * 2);
  p.ckv = (bf16*)take((size_t)NKROW * LDC * 2);
  p.kr = (bf16*)take((size_t)NKROW * 32 * 2);
  p.knope = (bf16*)take((size_t)NKROW * 256 * 2);
  p.vtm = (bf16*)take((size_t)3276800 * 2);
  size_t r2 = off;
  p.dq = (bf16*)take((size_t)NTOK * 256 * 2);
  p.dk = (bf16*)take((size_t)NTOK * 256 * 2);
  p.dv = (bf16*)take((size_t)NTOK * 256 * 2);
  p.dbeta = (float*)take((size_t)NTOK * 8 * 4);
  p.dg = (float*)take((size_t)NTOK * 8 * 4);
  p.sb = (bf16*)take((size_t)NTOK * 256 * 2);
  p.sc = (bf16*)take((size_t)NTOK * 256 * 2);
  if (off - r2 < (size_t)2 * NTOK * 256 * 4) off = r2 + (size_t)2 * NTOK * 256 * 4;
  p.ao = (bf16*)(ws + r2);
  p.sx = (bf16*)take((size_t)NTOK * 256 * 2);
  p.sdt = (float*)take((size_t)NTOK * 8 * 4);
  p.pu = (bf16*)take((size_t)1536 * 4096 * 2);
  p.pw = (bf16*)take((size_t)1536 * 4096 * 2);
  p.pqd = (bf16*)take((size_t)1536 * 4096 * 2);
  p.pqk = (bf16*)take((size_t)1536 * 4096 * 2);
  p.pkd = (bf16*)take((size_t)1536 * 4096 * 2);
  p.pgl = (float*)take(1536 * 4);
  p.pst = (bf16*)take((size_t)1536 * 8192 * 2);
  p.pcd = (bf16*)take((size_t)1536 * 8192 * 2);
  p.plast = (float*)take(1536 * 4);
  p.of = (bf16*)take((size_t)NTOK * 256 * 2);
  p.ob = (bf16*)take((size_t)NTOK * 256 * 2);
  p.yf = (float*)take((size_t)NTOK * 256 * 4);
  p.yb = (float*)take((size_t)NTOK * 256 * 4);
  p.bar = (unsigned*)take((size_t)(XCD_BAR_WORDS + 8192 + 4096) * 4);
  p.act = (bf16*)(ws + r1);
  size_t need = off;
  if (r1 + (size_t)NTOK * LDACT * 2 > need) need = r1 + (size_t)NTOK * LDACT * 2;
  if (need > ws_size) { fprintf(stderr, "kernel_launch: workspace too small: need %zu have %zu\n", need, ws_size); return; }
  hipMemsetAsync(p.bar, 0, (size_t)(XCD_BAR_WORDS + 8192 + 4096) * 4, stream);
#if MULTI_LAUNCH
  for (int ph = 0; ph < NPHASE; ++ph) {
    hipLaunchKernelGGL(mega, dim3(grid_blocks), dim3(NTHR), 0, stream, p, ph, ph + 1, 0);
  }
#else
  int lo = 0, hi = NPHASE, coop = 1;
  void* args[] = {&p, &lo, &hi, &coop};
  hipError_t e = hipLaunchCooperativeKernel((void*)mega, dim3(grid_blocks), dim3(NTHR), args, 0, stream);
  if (e != hipSuccess) fprintf(stderr, "cooperative launch failed: %s (grid %d)\n", hipGetErrorString(e), grid_blocks);
#endif
}
```

```cpp
#include <hip/hip_runtime.h>
#include <hip/hip_cooperative_groups.h>
#include <cstdio>
#include <cstring>
namespace cg = cooperative_groups;

#ifndef PROBE_MASK
#define PROBE_MASK 0
#endif
#ifndef MULTI_LAUNCH
#define MULTI_LAUNCH 0
#endif

typedef unsigned short bf16;
typedef short bf16x8 __attribute__((ext_vector_type(8)));
typedef float f32x4 __attribute__((ext_vector_type(4)));
typedef unsigned u32x4 __attribute__((ext_vector_type(4)));
typedef unsigned u32x2 __attribute__((ext_vector_type(2)));

#define NTHR 256
#define NTOK 12288
#define NPROMPT 4096
#define NKROW 12800
#define DM 1024
#define NPROJ 3328
#define DFF 4096
#define KPAD 64
#define LDH (DM + KPAD)
#define LDACT (DFF + KPAD)
#define LDQ (256 + KPAD)
#define LDC (128 + KPAD)
#define SMEM_BYTES 73728
#define ALPHA_F 1.681792830507429f
#define EPS_F 1e-6f
#define LOG2E 1.4426950408889634f

#define C_AQ 0
#define C_AK 256
#define C_AV 512
#define C_BQKV 768
#define C_BBETA 1536
#define C_BDECAY 1544
#define C_BGATE 1552
#define C_CQ 1808
#define C_CKV 2064
#define C_CKR 2192
#define C_DZ 2224
#define C_DXBC 2480
#define C_DDT 3248

#define O_Y 0
#define O_DK 12582912
#define O_DV 16777216
#define O_SD 20971520
#define O_CKV 23068672
#define O_KR 25165824
#define O_SS 25690112

struct P {
  const float* in[37];
  float* out;
  bf16 *winT, *woutT, *wff1T, *wff2T, *wuqT, *wukvT;
  float *mod, *ropeC, *ropeS;
  bf16 *hbf, *proj, *act;
  bf16 *qd, *kd, *vtd, *cqn, *qm, *ckv, *kr, *knope, *vtm;
  bf16 *dq, *dk, *dv; float *dbeta, *dg;
  bf16 *sx, *sb, *sc; float *sdt;
  bf16 *pu, *pw, *pqd, *pqk, *pkd; float *pgl;
  bf16 *pst, *pcd; float *plast;
  bf16 *of, *ob, *ao; float *yf, *yb;
  unsigned* bar;
};

typedef __bf16 hbf16x2 __attribute__((ext_vector_type(2)));
typedef float f32x2 __attribute__((ext_vector_type(2)));
__device__ __forceinline__ bf16 f2bf(float f) { __bf16 h = (__bf16)f; return __builtin_bit_cast(bf16, h); }
__device__ __forceinline__ float bf2f(bf16 h) { return __uint_as_float(((unsigned)h) << 16); }
__device__ __forceinline__ unsigned pack2(float a, float b) { f32x2 v = {a, b}; return __builtin_bit_cast(unsigned, __builtin_convertvector(v, hbf16x2)); }
__device__ __forceinline__ float lo2f(unsigned u) { return __uint_as_float(u << 16); }
__device__ __forceinline__ float hi2f(unsigned u) { return __uint_as_float(u & 0xffff0000u); }
__device__ __forceinline__ bf16x8 pack8(f32x4 a, f32x4 b) {
  u32x4 r; r[0] = pack2(a[0], a[1]); r[1] = pack2(a[2], a[3]); r[2] = pack2(b[0], b[1]); r[3] = pack2(b[2], b[3]);
  return __builtin_bit_cast(bf16x8, r);
}
__device__ __forceinline__ f32x4 mfma(bf16x8 a, bf16x8 b, f32x4 c) { return __builtin_amdgcn_mfma_f32_16x16x32_bf16(a, b, c, 0, 0, 0); }
__device__ __forceinline__ float ex2(float x) { return __builtin_amdgcn_exp2f(x); }
__device__ __forceinline__ float siluf(float x) { return x / (1.f + __expf(-x)); }
__device__ __forceinline__ float sigmoidf_(float x) { return 1.f / (1.f + __expf(-x)); }
__device__ __forceinline__ float softplusf_(float x) { return x > 20.f ? x : log1pf(__expf(x)); }
__device__ __forceinline__ int get_tid() { int t = threadIdx.x; asm volatile("" : "+v"(t)); return t; }
__device__ __forceinline__ float wave_sum(float v) {
#pragma unroll
  for (int o = 32; o >= 1; o >>= 1) v += __shfl_xor(v, o);
  return v;
}
__device__ __forceinline__ int permk(int k) { int kk = k & 31; return (k & ~31) + 8 * ((kk & 15) >> 2) + (kk & 3) + ((kk >> 4) << 2); }

__device__ __forceinline__ void tok_info(int r, int& seq, int& pos, int& L, int& krow, int& modi) {
  if (r < NPROMPT) { seq = r >> 8; pos = r & 255; L = 256; krow = r; modi = 0; }
  else { int rr = r - NPROMPT; int b = rr >> 12; seq = 16 + b; pos = rr & 4095; L = 4096; krow = NPROMPT + b * 4352 + pos; modi = 1 + b; }
}
__device__ __forceinline__ void seq_info(int seq, int& row0, int& L, int& krow0, int& Lk, long& vtbase) {
  if (seq < 16) { row0 = seq * 256; L = 256; krow0 = row0; Lk = 256; vtbase = (long)seq * 65536; }
  else { int b = seq - 16; row0 = NPROMPT + b * 4096; L = 4096; krow0 = NPROMPT + b * 4352; Lk = 4352; vtbase = 1048576L + (long)b * (256L * 4352L); }
}


#define XB_TMO      128
#define XB_XCNT(j)  (256  + 64 * (j))
#define XB_XSUB(j)  (1280 + 64 * (j))
#define XB_XGEN(j)  (2304 + 64 * (j))
#define XB_TOP      3328
#define XB_TOPGEN   3392
#define XCD_BAR_WORDS 3456
#define XB_SPIN_CAP (1u << 20)
#define LAS __attribute__((address_space(3)))
__device__ __forceinline__ unsigned xb_ld(unsigned* p)              { return __hip_atomic_load(p, __ATOMIC_RELAXED, __HIP_MEMORY_SCOPE_AGENT); }
__device__ __forceinline__ unsigned xb_add(unsigned* p, unsigned v) { return __hip_atomic_fetch_add(p, v, __ATOMIC_RELAXED, __HIP_MEMORY_SCOPE_AGENT); }
__device__ __forceinline__ unsigned xb_xcc_id() { return (unsigned)__builtin_amdgcn_s_getreg((3 << 11) | 20) & 0xFu; }
#define XB_SPIN(cond, bar) do { unsigned _sp = 0; while (cond) { __builtin_amdgcn_s_sleep(1); \
    if ((++_sp & 255u) == 0u) { if (xb_ld(&(bar)[XB_TMO])) break; if (_sp > XB_SPIN_CAP) { atomicAdd(&(bar)[XB_TMO], 1u); break; } } } } while (0)
struct XcdBarrier { unsigned* bar; unsigned x; volatile LAS unsigned* st; };
__device__ __forceinline__ XcdBarrier xcd_barrier_post(unsigned* bar, volatile LAS unsigned* st) {
  XcdBarrier b; b.bar = bar; b.x = xb_xcc_id(); b.st = st;
  if (threadIdx.x == 0) (void)xb_add(&bar[XB_XCNT(b.x)], 1u);
  return b;
}
__device__ __forceinline__ void xcd_barrier_complete(unsigned* bar, unsigned x, unsigned& nloc, unsigned& nx) {
  const unsigned G = gridDim.x * gridDim.y * gridDim.z;
  unsigned sum, cnt, mine, sp = 0u;
  for (;;) {
    sum = 0u; cnt = 0u; mine = 0u;
#pragma unroll
    for (unsigned j = 0; j < 16; ++j) { const unsigned c = xb_ld(&bar[XB_XCNT(j)]); sum += c; cnt += (c > 0u) ? 1u : 0u; mine = (j == x) ? c : mine; }
    if (sum == G) break;
    __builtin_amdgcn_s_sleep(1);
    if ((++sp & 255u) == 0u) { if (xb_ld(&bar[XB_TMO])) break; if (sp > XB_SPIN_CAP) { atomicAdd(&bar[XB_TMO], 1u); break; } }
  }
  nloc = mine > 0u ? mine : 1u; nx = cnt > 0u ? cnt : 1u;
}
__device__ __forceinline__ void xcd_barrier(const XcdBarrier& b) {
  asm volatile("s_waitcnt vmcnt(0)" ::: "memory");
  __syncthreads();
  if (threadIdx.x == 0) {
    unsigned* bar = b.bar;
    __builtin_amdgcn_s_waitcnt(0);
    unsigned nloc = b.st[0], nx = b.st[1];
    if (nloc == 0u) { xcd_barrier_complete(bar, b.x, nloc, nx); b.st[0] = nloc; b.st[1] = nx; }
    const unsigned old = xb_add(&bar[XB_XSUB(b.x)], 1u);
    const unsigned gen = old / nloc;
    if (old + 1u == (gen + 1u) * nloc) {
      __builtin_amdgcn_fence(__ATOMIC_RELEASE, "agent");
      asm volatile("s_waitcnt vmcnt(0)" ::: "memory");
      const unsigned og = xb_add(&bar[XB_TOP], 1u);
      const unsigned tg = og / nx;
      if (og + 1u == (tg + 1u) * nx) xb_add(&bar[XB_TOPGEN], 1u);
      else XB_SPIN(xb_ld(&bar[XB_TOPGEN]) == tg, bar);
      __builtin_amdgcn_fence(__ATOMIC_ACQUIRE, "agent");
      xb_add(&bar[XB_XGEN(b.x)], 1u);
      asm volatile("s_waitcnt vmcnt(0)" ::: "memory");
    } else {
      XB_SPIN(xb_ld(&bar[XB_XGEN(b.x)]) == gen, bar);
      __builtin_amdgcn_fence(__ATOMIC_ACQUIRE, "agent");
      asm volatile("s_waitcnt vmcnt(0)" ::: "memory");
    }
  }
  __syncthreads();
}

#define GSTR 144
template <class Epi>
__device__ __forceinline__ void gemm_tile(const bf16* __restrict__ A, int lda, const bf16* __restrict__ Bt, int ldb, int K,
                                          int m0, int n0, char* smem, Epi epi) {
  const int tid = get_tid(), lane = tid & 63, w = tid >> 6, g = lane >> 4, lr = lane & 15;
  const int wm = w >> 1, wn = w & 1;
  constexpr int GT = 128 * 128;
  constexpr int GBUF = 2 * GT;
  f32x4 acc[4][4];
#pragma unroll
  for (int i = 0; i < 4; ++i)
#pragma unroll
    for (int j = 0; j < 4; ++j) acc[i][j] = (f32x4){0.f, 0.f, 0.f, 0.f};
  const int nk = K >> 6;
  const int srow = 8 * w + (lane >> 3);
  const int spc = (lane & 7) ^ ((srow >> 1) & 7);
  const bf16* Ag = A + (long)(m0 + srow) * lda + spc * 8;
  const bf16* Bg = Bt + (long)(n0 + srow) * ldb + spc * 8;
  const long a32 = (long)32 * lda, b32 = (long)32 * ldb;
  typedef __attribute__((address_space(3))) unsigned lds_u32;
#define G_ISSUE(BUF, KT) { _Pragma("unroll") for (int i = 0; i < 4; ++i) { \
    __builtin_amdgcn_global_load_lds((const unsigned*)(Ag + i * a32 + (KT) * 64), (lds_u32*)(smem + (BUF) * GBUF + (i * 4 + w) * 1024), 16, 0, 0); \
    __builtin_amdgcn_global_load_lds((const unsigned*)(Bg + i * b32 + (KT) * 64), (lds_u32*)(smem + (BUF) * GBUF + GT + (i * 4 + w) * 1024), 16, 0, 0); } }
  const int sw = (lr >> 1) & 7;
  G_ISSUE(0, 0);
  asm volatile("s_waitcnt vmcnt(0)" ::: "memory");
  __syncthreads();
  for (int kt = 0; kt < nk; ++kt) {
    const int cur = kt & 1;
    if (kt + 1 < nk) G_ISSUE(cur ^ 1, kt + 1);
    bf16x8 a[2][4], b[2][4];
#pragma unroll
    for (int ks = 0; ks < 2; ++ks) {
      const int pc = ((ks * 4 + g) ^ sw) * 16;
#pragma unroll
      for (int i = 0; i < 4; ++i) {
        a[ks][i] = *(const bf16x8*)(smem + cur * GBUF + (wm * 64 + i * 16 + lr) * 128 + pc);
        b[ks][i] = *(const bf16x8*)(smem + cur * GBUF + GT + (wn * 64 + i * 16 + lr) * 128 + pc);
      }
    }
    __builtin_amdgcn_sched_barrier(0);
#pragma unroll
    for (int ks = 0; ks < 2; ++ks)
#pragma unroll
      for (int i = 0; i < 4; ++i)
#pragma unroll
        for (int j = 0; j < 4; ++j) acc[i][j] = mfma(a[ks][i], b[ks][j], acc[i][j]);
    __builtin_amdgcn_sched_barrier(0);
    asm volatile("s_waitcnt vmcnt(0)" ::: "memory");
    __syncthreads();
  }
#undef G_ISSUE
  if constexpr (Epi::STAGED) {
    char* sC = smem + w * 9216;
#pragma unroll
    for (int i = 0; i < 4; ++i)
#pragma unroll
      for (int j = 0; j < 4; ++j) {
        f32x4 v = epi.transform(m0 + wm * 64 + i * 16 + g * 4, n0 + wn * 64 + j * 16 + lr, acc[i][j]);
#pragma unroll
        for (int q = 0; q < 4; ++q) *(bf16*)(sC + (i * 16 + g * 4 + q) * GSTR + (j * 16 + lr) * 2) = f2bf(v[q]);
      }
#pragma unroll
    for (int q = 0; q < 8; ++q) {
      int id = lane + 64 * q, row = id >> 3, ch = id & 7;
      u32x4 v = *(const u32x4*)(sC + row * GSTR + ch * 16);
      *(u32x4*)(epi.dst + (long)(m0 + wm * 64 + row) * epi.ld + n0 + wn * 64 + ch * 8) = v;
    }
    __syncthreads();
  } else {
#pragma unroll
    for (int i = 0; i < 4; ++i)
#pragma unroll
      for (int j = 0; j < 4; ++j) epi(m0 + wm * 64 + i * 16 + g * 4, n0 + wn * 64 + j * 16 + lr, acc[i][j]);
  }
}

struct Sched { int xcc, rank, nloc, ok; volatile __attribute__((address_space(3))) unsigned* st; };
__device__ __forceinline__ bool sched_tile(const Sched& sc, int MT, int NT, int PW, int iter, int& mt, int& nt) {
  if (!sc.ok) {
    int t = blockIdx.x + iter * gridDim.x;
    if (t >= MT * NT) return false;
    mt = t / NT; nt = t % NT; return true;
  }
  const int m_lo = (sc.xcc * MT) >> 3, m_hi = ((sc.xcc + 1) * MT) >> 3, Mr = m_hi - m_lo;
  int q = sc.rank + iter * sc.nloc;
  if (q >= Mr * NT) return false;
  const int per = Mr * PW, nfull = NT / PW;
  int pnl = q / per, w = PW;
  if (pnl >= nfull) { pnl = nfull; w = NT - nfull * PW; }
  const int within = q - pnl * per;
  mt = m_lo + within / w; nt = pnl * PW + within % w;
  return true;
}

__device__ __forceinline__ void pre_item(const P& p, int item, char* smem) {
  const int tid = get_tid();
  if (item == 192) {
    for (int i = tid; i < 512; i += NTHR) {
      int pos = i >> 3, f = i & 7;
      float inv = expf(-(float)f * 0.125f * 9.210340371976184f);
      float s, c; sincosf((float)pos * inv, &s, &c);
      p.ropeC[i] = c; p.ropeS[i] = s;
    }
    return;
  }
  const int l = item / 48, cgp = item % 48, c0 = cgp * 128;
  float* sv = (float*)smem;
  float* red = (float*)(smem + 12288);
  for (int i = tid; i < 3072; i += NTHR) {
    int m = i >> 10, k = i & 1023;
    float x = (m == 0) ? p.in[9][k] : p.in[8][(m - 1) * 1024 + k];
    sv[i] = siluf(x);
  }
  __syncthreads();
  const int cl = tid & 31, ksub = tid >> 5;
  float acc[3][4];
#pragma unroll
  for (int m = 0; m < 3; ++m)
#pragma unroll
    for (int j = 0; j < 4; ++j) acc[m][j] = 0.f;
  const float* wp = p.in[10] + (long)l * 1024 * 6144 + c0 + cl * 4;
#pragma unroll 4
  for (int k = ksub; k < 1024; k += 8) {
    f32x4 w4 = __builtin_nontemporal_load((const f32x4*)(wp + (long)k * 6144));
    float s0 = sv[k], s1 = sv[1024 + k], s2 = sv[2048 + k];
#pragma unroll
    for (int j = 0; j < 4; ++j) { acc[0][j] += s0 * w4[j]; acc[1][j] += s1 * w4[j]; acc[2][j] += s2 * w4[j]; }
  }
#pragma unroll
  for (int m = 0; m < 3; ++m)
#pragma unroll
    for (int j = 0; j < 4; ++j) red[(ksub * 3 + m) * 128 + cl * 4 + j] = acc[m][j];
  __syncthreads();
  for (int i = tid; i < 384; i += NTHR) {
    int m = i >> 7, c = i & 127;
    float s = 0.f;
#pragma unroll
    for (int q = 0; q < 8; ++q) s += red[(q * 3 + m) * 128 + c];
    p.mod[((long)l * 3 + m) * 6144 + c0 + c] = s + p.in[11][l * 6144 + c0 + c];
  }
  __syncthreads();
}

__device__ __forceinline__ void wconv_tile(const float* __restrict__ W, int K, int N, bf16* __restrict__ Wt, int kt, int nt, char* smem) {
  float* T = (float*)smem;
  const int tid = get_tid();
  {
    int kk = tid >> 2, cc = (tid & 3) * 16;
#pragma unroll
    for (int q = 0; q < 4; ++q) {
      int n = nt * 64 + cc + q * 4;
      f32x4 v = (f32x4){0.f, 0.f, 0.f, 0.f};
      if (n < N) v = __builtin_nontemporal_load((const f32x4*)(W + (long)(kt * 64 + kk) * N + n));
#pragma unroll
      for (int j = 0; j < 4; ++j) T[kk * 65 + cc + q * 4 + j] = v[j];
    }
  }
  __syncthreads();
  {
    int n = tid >> 2, kc = (tid & 3) * 16;
    u32x4 o0, o1;
#pragma unroll
    for (int q = 0; q < 4; ++q) {
      o0[q] = pack2(T[(kc + 2 * q) * 65 + n], T[(kc + 2 * q + 1) * 65 + n]);
      o1[q] = pack2(T[(kc + 8 + 2 * q) * 65 + n], T[(kc + 8 + 2 * q + 1) * 65 + n]);
    }
    bf16* dst = Wt + (long)(nt * 64 + n) * (K + KPAD) + kt * 64 + kc;
    *(u32x4*)dst = o0;
    *(u32x4*)(dst + 8) = o1;
  }
  __syncthreads();
}

#define WC_IN 832
#define WC_OUT 256
#define WC_FF1 1024
#define WC_FF2 1024
#define WC_UQ 24
#define WC_UK 8
#define WC_UV 8
#define WC_TOTAL (WC_IN + WC_OUT + WC_FF1 + WC_FF2 + WC_UQ + WC_UK + WC_UV)

__device__ __forceinline__ void wconv_item(const P& p, int l, int it, char* smem) {
  const float* W; int K, N, ntn; bf16* Wt;
  if (it < WC_IN) { W = p.in[12] + (long)l * 1024 * 3256; K = 1024; N = 3256; Wt = p.winT; ntn = 52; }
  else if ((it -= WC_IN) < WC_OUT) { W = p.in[30] + (long)l * 1024 * 1024; K = 1024; N = 1024; Wt = p.woutT; ntn = 16; }
  else if ((it -= WC_OUT) < WC_FF1) { W = p.in[35] + (long)l * 1024 * 4096; K = 1024; N = 4096; Wt = p.wff1T; ntn = 64; }
  else if ((it -= WC_FF1) < WC_FF2) { W = p.in[36] + (long)l * 4096 * 1024; K = 4096; N = 1024; Wt = p.wff2T; ntn = 16; }
  else if ((it -= WC_FF2) < WC_UQ) { W = p.in[21] + (long)l * 256 * 384; K = 256; N = 384; Wt = p.wuqT; ntn = 6; }
  else if ((it -= WC_UQ) < WC_UK) { W = p.in[22] + (long)l * 128 * 256; K = 128; N = 256; Wt = p.wukvT; ntn = 4; }
  else { it -= WC_UK; W = p.in[23] + (long)l * 128 * 256; K = 128; N = 256; Wt = p.wukvT + 256 * LDC; ntn = 4; }
  wconv_tile(W, K, N, Wt, it / ntn, it % ntn, smem);
}

__device__ __forceinline__ void lnmod_rows(const P& p, int item, int mode, const float* lg, const float* lb, int l, int shift_idx, int scale_idx) {
  constexpr int LNR = 2;
  const int tid_ = get_tid(); const int lane = tid_ & 63, w = tid_ >> 6;
  const int rbase = item * (4 * LNR) + w * LNR;
  f32x4 v[LNR][4];
  if (mode == 0) {
#pragma unroll
    for (int q = 0; q < LNR; ++q) {
      const int r = rbase + q;
      const float* src = (r < NPROMPT) ? (p.in[0] + (long)r * DM) : (p.in[1] + (long)(r - NPROMPT) * DM);
#pragma unroll
      for (int i = 0; i < 4; ++i) v[q][i] = *(const f32x4*)(src + lane * 4 + 256 * i);
    }
  } else {
    u32x2 u[LNR][4];
#pragma unroll
    for (int q = 0; q < LNR; ++q)
#pragma unroll
      for (int i = 0; i < 4; ++i) u[q][i] = *(const u32x2*)((const bf16*)p.out + (long)(rbase + q) * 2048 + 1024 + lane * 4 + 256 * i);
    f32x4 gg[4], bb[4];
#pragma unroll
    for (int i = 0; i < 4; ++i) { gg[i] = *(const f32x4*)(lg + lane * 4 + 256 * i); bb[i] = *(const f32x4*)(lb + lane * 4 + 256 * i); }
#pragma unroll
    for (int q = 0; q < LNR; ++q) {
#pragma unroll
      for (int i = 0; i < 4; ++i) { v[q][i][0] = lo2f(u[q][i][0]); v[q][i][1] = hi2f(u[q][i][0]); v[q][i][2] = lo2f(u[q][i][1]); v[q][i][3] = hi2f(u[q][i][1]); }
      float s = 0.f;
#pragma unroll
      for (int i = 0; i < 4; ++i) s += v[q][i][0] + v[q][i][1] + v[q][i][2] + v[q][i][3];
      s = wave_sum(s);
      const float mu = s * (1.f / 1024.f);
      float qq = 0.f;
#pragma unroll
      for (int i = 0; i < 4; ++i)
#pragma unroll
        for (int j = 0; j < 4; ++j) { float d = v[q][i][j] - mu; qq += d * d; }
      qq = wave_sum(qq);
      const float rs = rsqrtf(qq * (1.f / 1024.f) + EPS_F);
#pragma unroll
      for (int i = 0; i < 4; ++i)
#pragma unroll
        for (int j = 0; j < 4; ++j) v[q][i][j] = (v[q][i][j] - mu) * rs * gg[i][j] + bb[i][j];
    }
  }
  if (mode == 2) {
#pragma unroll
    for (int q = 0; q < LNR; ++q)
#pragma unroll
      for (int i = 0; i < 4; ++i) *(f32x4*)(p.out + (long)(rbase + q) * DM + lane * 4 + 256 * i) = v[q][i];
    return;
  }
  const int modi = (rbase < NPROMPT) ? 0 : 1 + ((rbase - NPROMPT) >> 12);
  const float* md = p.mod + ((long)l * 3 + modi) * 6144;
  f32x4 sh[4], scl[4];
#pragma unroll
  for (int i = 0; i < 4; ++i) { sh[i] = *(const f32x4*)(md + shift_idx * 1024 + lane * 4 + 256 * i); scl[i] = *(const f32x4*)(md + scale_idx * 1024 + lane * 4 + 256 * i); }
#pragma unroll
  for (int q = 0; q < LNR; ++q) {
    const int r = rbase + q;
    bf16* rowb = (bf16*)p.out + (long)r * 2048;
#pragma unroll
    for (int i = 0; i < 4; ++i) {
      u32x2 o; o[0] = pack2(v[q][i][0], v[q][i][1]); o[1] = pack2(v[q][i][2], v[q][i][3]);
      *(u32x2*)(rowb + lane * 4 + 256 * i) = o;
      u32x2 h;
      h[0] = pack2(v[q][i][0] * (1.f + scl[i][0]) + sh[i][0], v[q][i][1] * (1.f + scl[i][1]) + sh[i][1]);
      h[1] = pack2(v[q][i][2] * (1.f + scl[i][2]) + sh[i][2], v[q][i][3] * (1.f + scl[i][3]) + sh[i][3]);
      *(u32x2*)(p.hbf + (long)r * LDH + lane * 4 + 256 * i) = h;
    }
  }
}

__device__ __forceinline__ void rope_cs(const P& p, int pos, int d, float& c, float& s) {
  int q = d >> 3, f = d & 7;
  int pp = (q < 2) ? (pos >> 6) : (pos & 63);
  c = p.ropeC[pp * 8 + f]; s = p.ropeS[pp * 8 + f];
}

#define PT 32
#define NT_OWN (NTOK / PT)
#define NT_PAST (512 / PT)
__device__ __forceinline__ void prep_diff(const P& p, int l, int tile) {
  const int tid = get_tid();
  const bool past = tile >= NT_OWN;
  int r0 = 0, seq, pos0, L, krow0, modi;
  const float* ck = nullptr; const float* cv = nullptr;
  if (!past) { r0 = tile * PT; tok_info(r0, seq, pos0, L, krow0, modi); }
  else {
    int b = (tile - NT_OWN) / (256 / PT), j0 = ((tile - NT_OWN) % (256 / PT)) * PT;
    seq = 16 + b; pos0 = 4096 + j0; krow0 = NPROMPT + b * 4352 + 4096 + j0;
    ck = p.in[2] + ((long)(b * 4 + l) * 256 + j0) * 256;
    cv = p.in[3] + ((long)(b * 4 + l) * 256 + j0) * 256;
  }
  const bool sample = seq >= 16;
  const int d = tid & 31, qd = d >> 3;
  const float sg = (qd & 1) ? 1.f : -1.f;
  for (int i0 = 0; i0 < PT; i0 += 8) {
    if (!past) {
      float q[8], k[8], qp[8], kp[8];
#pragma unroll
      for (int t = 0; t < 8; ++t) {
        const bf16* pr = p.proj + (long)(r0 + i0 + t) * NPROJ;
        q[t] = bf2f(pr[C_AQ + tid]); k[t] = bf2f(pr[C_AK + tid]);
        qp[t] = bf2f(pr[C_AQ + (tid ^ 8)]); kp[t] = bf2f(pr[C_AK + (tid ^ 8)]);
      }
#pragma unroll
      for (int t = 0; t < 8; ++t) {
        const int i = i0 + t;
        float qq = q[t], kk = k[t];
        if (!sample) {
          p.out[O_DK + ((long)(seq * 4 + l) * 256 + pos0 + i) * 256 + tid] = kk;
        } else {
          float c, sn; rope_cs(p, pos0 + i, d, c, sn);
          qq = qq * c + sg * qp[t] * sn;
          kk = kk * c + sg * kp[t] * sn;
        }
        p.qd[(long)(r0 + i) * 256 + tid] = f2bf(qq * (0.17677669529663687f * LOG2E));
        p.kd[(long)(krow0 + i) * 256 + tid] = f2bf(kk);
      }
    } else {
      float k[8];
#pragma unroll
      for (int t = 0; t < 8; ++t) k[t] = ck[(i0 + t) * 256 + tid];
#pragma unroll
      for (int t = 0; t < 8; ++t) p.kd[(long)(krow0 + i0 + t) * 256 + tid] = f2bf(k[t]);
    }
  }
  int row0s, Ls, krow0s, Lk; long vtbase;
  seq_info(seq, row0s, Ls, krow0s, Lk, vtbase);
  const int key0 = pos0;
  for (int o0 = 0; o0 < PT / 8; o0 += 4) {
    float vv[4][8];
#pragma unroll
    for (int o = 0; o < 4; ++o)
#pragma unroll
      for (int j = 0; j < 8; ++j) {
        if (!past) vv[o][j] = bf2f(p.proj[(long)(r0 + (o0 + o) * 8 + j) * NPROJ + C_AV + tid]);
        else vv[o][j] = cv[((o0 + o) * 8 + j) * 256 + tid];
      }
#pragma unroll
    for (int o = 0; o < 4; ++o) {
      if (!past && !sample) {
#pragma unroll
        for (int j = 0; j < 8; ++j) p.out[O_DV + ((long)(seq * 4 + l) * 256 + pos0 + (o0 + o) * 8 + j) * 256 + tid] = vv[o][j];
      }
      u32x4 pk; pk[0] = pack2(vv[o][0], vv[o][1]); pk[1] = pack2(vv[o][2], vv[o][3]); pk[2] = pack2(vv[o][4], vv[o][5]); pk[3] = pack2(vv[o][6], vv[o][7]);
      *(u32x4*)(p.vtd + vtbase + (long)tid * Lk + key0 + (o0 + o) * 8) = pk;
    }
  }
}

__device__ __forceinline__ void prep_mla(const P& p, int l, int tile) {
  const int tid_ = get_tid(); const int lane = tid_ & 63, w = tid_ >> 6;
  const bool past = tile >= NT_OWN;
  if (!past) {
    const f32x4 gq = *(const f32x4*)(p.in[19] + l * 256 + lane * 4);
    const float kv0 = p.in[20][l * 128 + lane * 2], kv1 = p.in[20][l * 128 + lane * 2 + 1];
    for (int ii0 = 0; ii0 < PT / 4; ii0 += 4) {
      u32x2 cq[4]; unsigned ck[4]; float krv[4];
#pragma unroll
      for (int t = 0; t < 4; ++t) {
        const bf16* pr = p.proj + (long)(tile * PT + (ii0 + t) * 4 + w) * NPROJ;
        cq[t] = *(const u32x2*)(pr + C_CQ + lane * 4);
        ck[t] = *(const unsigned*)(pr + C_CKV + lane * 2);
        krv[t] = bf2f(pr[C_CKR + (lane & 31)]);
      }
#pragma unroll
      for (int t = 0; t < 4; ++t) {
        int r = tile * PT + (ii0 + t) * 4 + w, seq, pos, L, krow, modi;
        tok_info(r, seq, pos, L, krow, modi);
        float a0 = lo2f(cq[t][0]), a1 = hi2f(cq[t][0]), a2 = lo2f(cq[t][1]), a3 = hi2f(cq[t][1]);
        float ss = wave_sum(a0 * a0 + a1 * a1 + a2 * a2 + a3 * a3);
        float rs = rsqrtf(ss * (1.f / 256.f) + EPS_F);
        u32x2 oq; oq[0] = pack2(a0 * rs * gq[0], a1 * rs * gq[1]); oq[1] = pack2(a2 * rs * gq[2], a3 * rs * gq[3]);
        *(u32x2*)(p.cqn + (long)r * LDQ + lane * 4) = oq;
        float b0 = lo2f(ck[t]), b1 = hi2f(ck[t]);
        float s2 = wave_sum(b0 * b0 + b1 * b1);
        float rs2 = rsqrtf(s2 * (1.f / 128.f) + EPS_F);
        b0 = b0 * rs2 * kv0; b1 = b1 * rs2 * kv1;
        *(unsigned*)(p.ckv + (long)krow * LDC + lane * 2) = pack2(b0, b1);
        float kr = krv[t];
        float kp = __shfl_xor(kr, 8);
        if (seq < 16) {
          long o = ((long)(seq * 4 + l) * 256 + pos);
          p.out[O_CKV + o * 128 + lane * 2] = b0; p.out[O_CKV + o * 128 + lane * 2 + 1] = b1;
          if (lane < 32) p.out[O_KR + o * 32 + lane] = kr;
        } else {
          float c, sn; rope_cs(p, pos, lane & 31, c, sn);
          float sg = ((lane >> 3) & 1) ? 1.f : -1.f;
          kr = kr * c + sg * kp * sn;
        }
        if (lane < 32) p.kr[(long)krow * 32 + lane] = f2bf(kr);
      }
    }
  } else {
    const int b = (tile - NT_OWN) / (256 / PT), j0 = ((tile - NT_OWN) % (256 / PT)) * PT;
    for (int ii0 = 0; ii0 < PT / 4; ii0 += 4) {
      float c1a[4], c1b[4], c2v[4];
#pragma unroll
      for (int t = 0; t < 4; ++t) {
        const int j = j0 + (ii0 + t) * 4 + w;
        const float* c1 = p.in[5] + ((long)(b * 4 + l) * 256 + j) * 128;
        const float* c2 = p.in[6] + ((long)(b * 4 + l) * 256 + j) * 32;
        c1a[t] = c1[lane * 2]; c1b[t] = c1[lane * 2 + 1]; c2v[t] = c2[lane & 31];
      }
#pragma unroll
      for (int t = 0; t < 4; ++t) {
        const int j = j0 + (ii0 + t) * 4 + w;
        const int krow = NPROMPT + b * 4352 + 4096 + j;
        *(unsigned*)(p.ckv + (long)krow * LDC + lane * 2) = pack2(c1a[t], c1b[t]);
        if (lane < 32) p.kr[(long)krow * 32 + lane] = f2bf(c2v[t]);
      }
    }
  }
}

__device__ __forceinline__ void prep_dn(const P& p, int l, int tile) {
  const int tid = get_tid();
  const int r0 = tile * PT;
  int seq, pos0, L, krow, modi;
  tok_info(r0, seq, pos0, L, krow, modi);
  const float* cw = p.in[15] + (long)l * 3 * 768;
  float w0[3], w1[3], w2[3];
#pragma unroll
  for (int c = 0; c < 3; ++c) { w0[c] = cw[c * 256 + tid]; w1[c] = cw[768 + c * 256 + tid]; w2[c] = cw[1536 + c * 256 + tid]; }
  const float alog = __expf(p.in[16][l * 8 + (tid & 7)]), dtb = p.in[17][l * 8 + (tid & 7)];
  const bf16* pj = p.proj + C_BQKV + tid;
  for (int i0 = 0; i0 < PT; i0 += 16) {
    float v[3][18];
#pragma unroll
    for (int t = 0; t < 18; ++t) {
      const int pos = pos0 + i0 + t - 1;
      const bool ok = (pos >= 0) && (pos < L) && (i0 + t - 1 >= 0 || pos0 > 0);
      const int rr = ok ? (r0 + i0 + t - 1) : r0;
#pragma unroll
      for (int c = 0; c < 3; ++c) { float x = bf2f(pj[(long)rr * NPROJ + c * 256]); v[c][t] = ok ? x : 0.f; }
    }
    float braw[16], draw[16];
#pragma unroll
    for (int t = 0; t < 16; ++t) {
      const bf16* pr = p.proj + (long)(r0 + i0 + t) * NPROJ;
      braw[t] = bf2f(pr[C_BBETA + (tid & 7)]); draw[t] = bf2f(pr[C_BDECAY + (tid & 7)]);
    }
#pragma unroll
    for (int t = 0; t < 16; ++t) {
      float y[3];
#pragma unroll
      for (int c = 0; c < 3; ++c) y[c] = siluf(w0[c] * v[c][t] + w1[c] * v[c][t + 1] + w2[c] * v[c][t + 2]);
      float sq = wave_sum(y[0] * y[0]);
      float sk = wave_sum(y[1] * y[1]);
      long o = (long)(r0 + i0 + t) * 256 + tid;
      p.dq[o] = f2bf(y[0] * rsqrtf(sq + EPS_F) * 0.125f); p.dk[o] = f2bf(y[1] * rsqrtf(sk + EPS_F)); p.dv[o] = f2bf(y[2]);
      if (tid < 8) {
        p.dbeta[(long)(r0 + i0 + t) * 8 + tid] = sigmoidf_(braw[t]);
        p.dg[(long)(r0 + i0 + t) * 8 + tid] = -alog * softplusf_(draw[t] + dtb);
      }
    }
  }
}

__device__ __forceinline__ void prep_ssd(const P& p, int l, int tile) {
  const int tid = get_tid();
  const int r0 = tile * PT;
  int seq, pos0, L, krow, modi;
  tok_info(r0, seq, pos0, L, krow, modi);
  const float* cw = p.in[24] + (long)l * 3 * 768;
  const float* cb = p.in[25] + (long)l * 768;
  float w0[3], w1[3], w2[3], bs[3];
#pragma unroll
  for (int c = 0; c < 3; ++c) { w0[c] = cw[c * 256 + tid]; w1[c] = cw[768 + c * 256 + tid]; w2[c] = cw[1536 + c * 256 + tid]; bs[c] = cb[c * 256 + tid]; }
  const float dtb = p.in[27][l * 8 + (tid & 7)];
  const bf16* pj = p.proj + C_DXBC + tid;
  for (int i0 = 0; i0 < PT; i0 += 16) {
    float v[3][18];
#pragma unroll
    for (int t = 0; t < 18; ++t) {
      const int pos = pos0 + i0 + t - 1;
      const bool ok = (pos >= 0) && (pos < L) && (i0 + t - 1 >= 0 || pos0 > 0);
      const int rr = ok ? (r0 + i0 + t - 1) : r0;
#pragma unroll
      for (int c = 0; c < 3; ++c) { float x = bf2f(pj[(long)rr * NPROJ + c * 256]); v[c][t] = ok ? x : 0.f; }
    }
    float draw[16];
#pragma unroll
    for (int t = 0; t < 16; ++t) draw[t] = bf2f(p.proj[(long)(r0 + i0 + t) * NPROJ + C_DDT + (tid & 7)]);
#pragma unroll
    for (int t = 0; t < 16; ++t) {
      long o = (long)(r0 + i0 + t) * 256 + tid;
      p.sx[o] = f2bf(siluf(w0[0] * v[0][t] + w1[0] * v[0][t + 1] + w2[0] * v[0][t + 2] + bs[0]));
      p.sb[o] = f2bf(siluf(w0[1] * v[1][t] + w1[1] * v[1][t + 1] + w2[1] * v[1][t + 2] + bs[1]));
      p.sc[o] = f2bf(siluf(w0[2] * v[2][t] + w1[2] * v[2][t + 1] + w2[2] * v[2][t + 2] + bs[2]));
      if (tid < 8) p.sdt[(long)(r0 + i0 + t) * 8 + tid] = softplusf_(draw[t] + dtb);
    }
  }
}

__device__ __forceinline__ void dn_chunk_prep(const P& p, int item, char* smem) {
  const int tid = get_tid(), lane = tid & 63, w = tid >> 6, g = lane >> 4, lr = lane & 15;
  const int dir = item & 1, h = (item >> 1) & 3, cgi = item >> 3;
  const int r0 = cgi * 64;
  char* sQ = smem; char* sK = smem + 9216; char* sV = smem + 18432;
  float* sA = (float*)(smem + 27648);
  bf16* sQKM = (bf16*)(smem + 44032);
  bf16* sW = (bf16*)(smem + 52224);
  float* sGc = (float*)(smem + 60416);
  float* sBeta = (float*)(smem + 60672);
  for (int id = tid; id < 512; id += NTHR) {
    int i = id >> 3, ch = id & 7;
    int r = r0 + (dir ? 63 - i : i);
    long go = (long)r * 256 + h * 64 + ch * 8;
    *(u32x4*)(sQ + i * 144 + ch * 16) = *(const u32x4*)(p.dq + go);
    *(u32x4*)(sK + i * 144 + ch * 16) = *(const u32x4*)(p.dk + go);
    *(u32x4*)(sV + i * 144 + ch * 16) = *(const u32x4*)(p.dv + go);
  }
  if (w == 0) {
    int r = r0 + (dir ? 63 - lane : lane);
    float gv = p.dg[(long)r * 8 + dir * 4 + h];
    sBeta[lane] = p.dbeta[(long)r * 8 + dir * 4 + h];
#pragma unroll
    for (int o = 1; o < 64; o <<= 1) { float t = __shfl_up(gv, o); if (lane >= o) gv += t; }
    sGc[lane] = gv;
  }
  __syncthreads();
  const float gl = sGc[63];
  if (tid == 0) p.pgl[item] = gl;
  {
    bf16x8 aK[2], aQ[2];
#pragma unroll
    for (int ks = 0; ks < 2; ++ks) {
      aK[ks] = *(const bf16x8*)(sK + (16 * w + lr) * 144 + ks * 64 + g * 16);
      aQ[ks] = *(const bf16x8*)(sQ + (16 * w + lr) * 144 + ks * 64 + g * 16);
    }
#pragma unroll
    for (int nt = 0; nt < 4; ++nt) {
      f32x4 kk = (f32x4){0.f, 0.f, 0.f, 0.f}, qk = (f32x4){0.f, 0.f, 0.f, 0.f};
#pragma unroll
      for (int ks = 0; ks < 2; ++ks) {
        bf16x8 bK = *(const bf16x8*)(sK + (16 * nt + lr) * 144 + ks * 64 + g * 16);
        kk = mfma(aK[ks], bK, kk);
        qk = mfma(aQ[ks], bK, qk);
      }
      const int jj = 16 * nt + lr;
      const float gj = sGc[jj];
#pragma unroll
      for (int j = 0; j < 4; ++j) {
        const int i = 16 * w + 4 * g + j;
        float dec = (i >= jj) ? __expf(sGc[i] - gj) : 0.f;
        sA[i * 64 + jj] = (i > jj) ? sBeta[i] * kk[j] * dec : 0.f;
        sQKM[i * 64 + permk(jj)] = f2bf(qk[j] * dec);
      }
    }
  }
  const long ob = (long)item * 4096;
  __syncthreads();
  if (tid < 128) {
    const int c = tid & 63;
    const bool isw = tid >= 64;
    const char* src = isw ? sK : sV;
    float acol[64], x[64];
#pragma unroll
    for (int i = 0; i < 64; ++i) acol[i] = sA[i * 64 + lane];
#pragma unroll
    for (int i = 0; i < 64; ++i) {
      float r = bf2f(*(const bf16*)(src + i * 144 + c * 2)) * sBeta[i];
      x[i] = isw ? r * __expf(sGc[i]) : r;
    }
#pragma unroll
    for (int i = 1; i < 64; ++i) {
      float acc0 = x[i], acc1 = 0.f;
#pragma unroll
      for (int j = 0; j < i; ++j) {
        const float a = __builtin_bit_cast(float, __builtin_amdgcn_readlane(__builtin_bit_cast(int, acol[i]), j));
        if (j & 1) acc1 -= a * x[j]; else acc0 -= a * x[j];
      }
      x[i] = acc0 + acc1;
    }
    if (!isw) {
#pragma unroll
      for (int q = 0; q < 8; ++q) {
        u32x4 o;
        o[0] = pack2(x[q * 8 + 0], x[q * 8 + 1]); o[1] = pack2(x[q * 8 + 2], x[q * 8 + 3]);
        o[2] = pack2(x[q * 8 + 4], x[q * 8 + 5]); o[3] = pack2(x[q * 8 + 6], x[q * 8 + 7]);
        *(u32x4*)(p.pu + ob + c * 64 + q * 8) = o;
      }
    } else {
      const int pc = permk(c);
#pragma unroll
      for (int i = 0; i < 64; ++i) sW[i * 64 + pc] = f2bf(x[i]);
    }
    } else {
    const int t2 = tid - 128;
    for (int id = t2; id < 512; id += 128) {
      int i = id >> 3, c8 = id & 7;
      int blk = (c8 >> 2) * 32, gg = c8 & 3;
      float e = __expf(sGc[i]);
      u32x2 lo = *(const u32x2*)(sQ + i * 144 + (blk + 4 * gg) * 2);
      u32x2 hi = *(const u32x2*)(sQ + i * 144 + (blk + 16 + 4 * gg) * 2);
      u32x4 o;
      o[0] = pack2(lo2f(lo[0]) * e, hi2f(lo[0]) * e); o[1] = pack2(lo2f(lo[1]) * e, hi2f(lo[1]) * e);
      o[2] = pack2(lo2f(hi[0]) * e, hi2f(hi[0]) * e); o[3] = pack2(lo2f(hi[1]) * e, hi2f(hi[1]) * e);
      *(u32x4*)(p.pqd + ob + i * 64 + c8 * 8) = o;
    }
    for (int id = t2; id < 512; id += 128) {
      int d = id >> 3, c8 = id & 7;
      int blk = (c8 >> 2) * 32, gg = c8 & 3;
      float vals[8];
#pragma unroll
      for (int e = 0; e < 8; ++e) {
        int i = blk + ((e < 4) ? (4 * gg + e) : (16 + 4 * gg + e - 4));
        vals[e] = bf2f(*(const bf16*)(sK + i * 144 + d * 2)) * __expf(gl - sGc[i]);
      }
      u32x4 o; o[0] = pack2(vals[0], vals[1]); o[1] = pack2(vals[2], vals[3]); o[2] = pack2(vals[4], vals[5]); o[3] = pack2(vals[6], vals[7]);
      *(u32x4*)(p.pkd + ob + d * 64 + c8 * 8) = o;
    }
    for (int id = t2; id < 512; id += 128) *(u32x4*)(p.pqk + ob + id * 8) = *(const u32x4*)(sQKM + id * 8);
  }
  __syncthreads();
  for (int id = tid; id < 512; id += NTHR) *(u32x4*)(p.pw + ob + id * 8) = *(const u32x4*)(sW + id * 8);
  __syncthreads();
}

__device__ __forceinline__ void ssd_chunk_prep(const P& p, int l, int item, char* smem) {
  const int tid = get_tid(), lane = tid & 63, w = tid >> 6, g = lane >> 4, lr = lane & 15;
  const int dir = item & 1, h = (item >> 1) & 3, cgi = item >> 3, gr = h >> 1;
  const int r0 = cgi * 64;
  char* sB = smem; char* sC = smem + 17408; char* sXT = smem + 34816; char* sBT = smem + 44032;
  float* sAc = (float*)(smem + 62464);
  float* sDt = (float*)(smem + 62720);
  if (w == 0) {
    int r = r0 + (dir ? 63 - lane : lane);
    float dt = p.sdt[(long)r * 8 + dir * 4 + h];
    float a = -__expf(p.in[26][l * 8 + dir * 4 + h]);
    float v = dt * a;
#pragma unroll
    for (int o = 1; o < 64; o <<= 1) { float t = __shfl_up(v, o); if (lane >= o) v += t; }
    sAc[lane] = v; sDt[lane] = dt;
  }
  for (int id = tid; id < 1024; id += NTHR) {
    int i = id >> 4, ch = id & 15;
    int r = r0 + (dir ? 63 - i : i);
    long go = (long)r * 256 + gr * 128 + ch * 8;
    *(u32x4*)(sB + i * 272 + ch * 16) = *(const u32x4*)(p.sb + go);
    *(u32x4*)(sC + i * 272 + ch * 16) = *(const u32x4*)(p.sc + go);
  }
  __syncthreads();
  const float last = sAc[63];
  if (tid == 0) p.plast[item] = last;
  for (int id = tid; id < 512; id += NTHR) {
    int i = id >> 3, ch = id & 7;
    int r = r0 + (dir ? 63 - i : i);
    u32x4 v = *(const u32x4*)(p.sx + (long)r * 256 + h * 64 + ch * 8);
    float dt = sDt[i];
#pragma unroll
    for (int q = 0; q < 4; ++q) {
      *(bf16*)(sXT + (ch * 8 + 2 * q) * 144 + i * 2) = f2bf(lo2f(v[q]) * dt);
      *(bf16*)(sXT + (ch * 8 + 2 * q + 1) * 144 + i * 2) = f2bf(hi2f(v[q]) * dt);
    }
  }
  for (int id = tid; id < 1024; id += NTHR) {
    int i = id >> 4, ch = id & 15;
    u32x4 v = *(const u32x4*)(sB + i * 272 + ch * 16);
    float e = __expf(last - sAc[i]);
#pragma unroll
    for (int q = 0; q < 4; ++q) {
      *(bf16*)(sBT + (ch * 8 + 2 * q) * 144 + i * 2) = f2bf(lo2f(v[q]) * e);
      *(bf16*)(sBT + (ch * 8 + 2 * q + 1) * 144 + i * 2) = f2bf(hi2f(v[q]) * e);
    }
  }
  const long ob = (long)item * 8192;
  for (int id = tid; id < 1024; id += NTHR) {
    int i = id >> 4, c8 = id & 15;
    int blk = (c8 >> 2) * 32, gg = c8 & 3;
    float e = __expf(sAc[i]);
    u32x2 lo = *(const u32x2*)(sC + i * 272 + (blk + 4 * gg) * 2);
    u32x2 hi = *(const u32x2*)(sC + i * 272 + (blk + 16 + 4 * gg) * 2);
    u32x4 o;
    o[0] = pack2(lo2f(lo[0]) * e, hi2f(lo[0]) * e); o[1] = pack2(lo2f(lo[1]) * e, hi2f(lo[1]) * e);
    o[2] = pack2(lo2f(hi[0]) * e, hi2f(hi[0]) * e); o[3] = pack2(lo2f(hi[1]) * e, hi2f(hi[1]) * e);
    *(u32x4*)(p.pcd + ob + i * 128 + c8 * 8) = o;
  }
  __syncthreads();
  f32x4 G[4];
#pragma unroll
  for (int mt = 0; mt < 4; ++mt) G[mt] = (f32x4){0.f, 0.f, 0.f, 0.f};
#pragma unroll
  for (int ks = 0; ks < 4; ++ks) {
    bf16x8 bC = *(const bf16x8*)(sC + (16 * w + lr) * 272 + ks * 64 + g * 16);
#pragma unroll
    for (int mt = 0; mt < 4; ++mt) {
      bf16x8 aB = *(const bf16x8*)(sB + (16 * mt + lr) * 272 + ks * 64 + g * 16);
      G[mt] = mfma(aB, bC, G[mt]);
    }
  }
  {
    const int i = 16 * w + lr;
    const float ai = sAc[i];
#pragma unroll
    for (int mt = 0; mt < 4; ++mt)
#pragma unroll
      for (int j = 0; j < 4; ++j) {
        int jj = 16 * mt + 4 * g + j;
        G[mt][j] = (i >= jj) ? G[mt][j] * __expf(ai - sAc[jj]) : 0.f;
      }
  }
  bf16x8 bM[2];
  bM[0] = pack8(G[0], G[1]); bM[1] = pack8(G[2], G[3]);
  {
    float* Y = dir ? p.yb : p.yf;
    const int i = 16 * w + lr;
    const int r = r0 + (dir ? 63 - i : i);
#pragma unroll
    for (int mp = 0; mp < 4; ++mp) {
      f32x4 y = (f32x4){0.f, 0.f, 0.f, 0.f};
#pragma unroll
      for (int kb = 0; kb < 2; ++kb) {
        u32x2 lo = *(const u32x2*)(sXT + (16 * mp + lr) * 144 + (kb * 32 + 4 * g) * 2);
        u32x2 hi = *(const u32x2*)(sXT + (16 * mp + lr) * 144 + (kb * 32 + 16 + 4 * g) * 2);
        u32x4 a; a[0] = lo[0]; a[1] = lo[1]; a[2] = hi[0]; a[3] = hi[1];
        y = mfma(__builtin_bit_cast(bf16x8, a), bM[kb], y);
      }
      *(f32x4*)(Y + (long)r * 256 + h * 64 + 16 * mp + 4 * g) = y;
    }
  }
  {
    bf16x8 bX[2];
#pragma unroll
    for (int ks = 0; ks < 2; ++ks) bX[ks] = *(const bf16x8*)(sXT + (16 * w + lr) * 144 + ks * 64 + g * 16);
#pragma unroll
    for (int mt = 0; mt < 8; ++mt) {
      f32x4 s = (f32x4){0.f, 0.f, 0.f, 0.f};
#pragma unroll
      for (int ks = 0; ks < 2; ++ks) {
        bf16x8 a = *(const bf16x8*)(sBT + (16 * mt + lr) * 144 + ks * 64 + g * 16);
        s = mfma(a, bX[ks], s);
      }
      u32x2 o; o[0] = pack2(s[0], s[1]); o[1] = pack2(s[2], s[3]);
      *(u32x2*)(p.pst + ob + (16 * w + lr) * 128 + 16 * mt + 4 * g) = o;
    }
  }
  __syncthreads();
}

__device__ __forceinline__ void dn_chain(const P& p, int l, int cidx, char* smem) {
  const int tid = get_tid(), lane = tid & 63, w = tid >> 6, g = lane >> 4, lr = lane & 15;
  const int dir = cidx & 1, h = (cidx >> 1) & 3, seq = cidx >> 3;
  int row0, L, krow0, Lk; long vtb;
  seq_info(seq, row0, L, krow0, Lk, vtb);
  const int n = L >> 6, cg0 = row0 >> 6;
  const int dvc = 16 * w + lr;
  constexpr int MSZ = 64 * 144, STG = 4 * MSZ;
  f32x4 S[4];
  if (seq >= 16) {
    const float* s0 = p.in[4] + ((((long)(seq - 16) * 4 + l) * 2 + dir) * 4 + h) * 4096;
#pragma unroll
    for (int mt = 0; mt < 4; ++mt)
#pragma unroll
      for (int j = 0; j < 4; ++j) S[mt][j] = s0[(16 * mt + 4 * g + j) * 64 + dvc];
  } else {
#pragma unroll
    for (int mt = 0; mt < 4; ++mt) S[mt] = (f32x4){0.f, 0.f, 0.f, 0.f};
  }
  bf16* O = dir ? p.ob : p.of;
  u32x4 rg[8]; u32x2 un[4]; float gln;
  auto item_of = [&](int c) __attribute__((always_inline)) { const int oc = dir ? n - 1 - c : c; return ((cg0 + oc) * 4 + h) * 2 + dir; };
  auto gload = [&](int item) __attribute__((always_inline)) {
    const long ob = (long)item * 4096;
#pragma unroll
    for (int i = 0; i < 8; ++i) {
      const int mat = i >> 1, rem = tid + 256 * (i & 1);
      const bf16* base = (mat == 0) ? p.pw : (mat == 1) ? p.pqd : (mat == 2) ? p.pqk : p.pkd;
      rg[i] = *(const u32x4*)(base + ob + rem * 8);
    }
#pragma unroll
    for (int mt = 0; mt < 4; ++mt) un[mt] = *(const u32x2*)(p.pu + ob + dvc * 64 + 16 * mt + 4 * g);
    gln = p.pgl[item];
  };
  auto sstore = [&](int st) __attribute__((always_inline)) {
#pragma unroll
    for (int i = 0; i < 8; ++i) {
      const int mat = i >> 1, rem = tid + 256 * (i & 1), row = rem >> 3, ch = rem & 7;
      *(u32x4*)(smem + st * STG + mat * MSZ + row * 144 + ch * 16) = rg[i];
    }
  };
  gload(item_of(0));
  sstore(0);
  __syncthreads();
  for (int c = 0; c < n; ++c) {
    const int oc = dir ? n - 1 - c : c;
    u32x2 uc[4];
#pragma unroll
    for (int mt = 0; mt < 4; ++mt) uc[mt] = un[mt];
    const float egl = __expf(gln);
    if (c + 1 < n) gload(item_of(c + 1));
    __builtin_amdgcn_sched_barrier(0);
    const char* sb = smem + (c & 1) * STG + lr * 144 + g * 16;
    bf16x8 bS[2];
    bS[0] = pack8(S[0], S[1]); bS[1] = pack8(S[2], S[3]);
    f32x4 vn[4], o[4];
#pragma unroll
    for (int mt = 0; mt < 4; ++mt) {
      f32x4 a = (f32x4){0.f, 0.f, 0.f, 0.f}, b = (f32x4){0.f, 0.f, 0.f, 0.f};
#pragma unroll
      for (int ks = 0; ks < 2; ++ks) {
        bf16x8 aw = *(const bf16x8*)(sb + 0 * MSZ + mt * 16 * 144 + ks * 64);
        bf16x8 aq = *(const bf16x8*)(sb + 1 * MSZ + mt * 16 * 144 + ks * 64);
        a = mfma(aw, bS[ks], a);
        b = mfma(aq, bS[ks], b);
      }
      vn[mt][0] = lo2f(uc[mt][0]) - a[0]; vn[mt][1] = hi2f(uc[mt][0]) - a[1];
      vn[mt][2] = lo2f(uc[mt][1]) - a[2]; vn[mt][3] = hi2f(uc[mt][1]) - a[3];
      o[mt] = b;
    }
    bf16x8 bV[2];
    bV[0] = pack8(vn[0], vn[1]); bV[1] = pack8(vn[2], vn[3]);
#pragma unroll
    for (int mt = 0; mt < 4; ++mt) {
      f32x4 sn;
#pragma unroll
      for (int j = 0; j < 4; ++j) sn[j] = S[mt][j] * egl;
#pragma unroll
      for (int kb = 0; kb < 2; ++kb) {
        bf16x8 aqk = *(const bf16x8*)(sb + 2 * MSZ + mt * 16 * 144 + kb * 64);
        bf16x8 akd = *(const bf16x8*)(sb + 3 * MSZ + mt * 16 * 144 + kb * 64);
        o[mt] = mfma(aqk, bV[kb], o[mt]);
        sn = mfma(akd, bV[kb], sn);
      }
      S[mt] = sn;
    }
#pragma unroll
    for (int mt = 0; mt < 4; ++mt)
#pragma unroll
      for (int j = 0; j < 4; ++j) {
        int i = 16 * mt + 4 * g + j;
        int r = (cg0 + oc) * 64 + (dir ? 63 - i : i);
        O[(long)r * 256 + h * 64 + dvc] = f2bf(o[mt][j]);
      }
    __builtin_amdgcn_sched_barrier(0);
    if (c + 1 < n) sstore((c + 1) & 1);
    __syncthreads();
  }
  if (seq < 16) {
    float* so = p.out + O_SD + ((((long)seq * 4 + l) * 2 + dir) * 4 + h) * 4096;
#pragma unroll
    for (int mt = 0; mt < 4; ++mt)
#pragma unroll
      for (int j = 0; j < 4; ++j) so[(16 * mt + 4 * g + j) * 64 + dvc] = S[mt][j];
  }
}

__device__ __forceinline__ void ssd_chain(const P& p, int l, int cidx, char* smem) {
  const int tid = get_tid(), lane = tid & 63, w = tid >> 6, g = lane >> 4, lr = lane & 15;
  const int dir = cidx & 1, h = (cidx >> 1) & 3, seq = cidx >> 3;
  int row0, L, krow0, Lk; long vtb;
  seq_info(seq, row0, L, krow0, Lk, vtb);
  const int n = L >> 6, cg0 = row0 >> 6;
  const int pc = 16 * w + lr;
  constexpr int STG = 64 * 272;
  f32x4 S[8];
  if (seq >= 16) {
    const float* s0 = p.in[7] + ((((long)(seq - 16) * 4 + l) * 2 + dir) * 4 + h) * 8192;
#pragma unroll
    for (int mt = 0; mt < 8; ++mt) S[mt] = *(const f32x4*)(s0 + pc * 128 + 16 * mt + 4 * g);
  } else {
#pragma unroll
    for (int mt = 0; mt < 8; ++mt) S[mt] = (f32x4){0.f, 0.f, 0.f, 0.f};
  }
  float* Y = dir ? p.yb : p.yf;
  u32x4 rg[4]; u32x2 stn[8]; float yn[16]; float lastn;
  auto item_of = [&](int c) __attribute__((always_inline)) { const int oc = dir ? n - 1 - c : c; return ((cg0 + oc) * 4 + h) * 2 + dir; };
  auto gload = [&](int c) __attribute__((always_inline)) {
    const int oc = dir ? n - 1 - c : c;
    const int item = ((cg0 + oc) * 4 + h) * 2 + dir;
    const long ob = (long)item * 8192;
#pragma unroll
    for (int i = 0; i < 4; ++i) rg[i] = *(const u32x4*)(p.pcd + ob + (tid + 256 * i) * 8);
#pragma unroll
    for (int mt = 0; mt < 8; ++mt) stn[mt] = *(const u32x2*)(p.pst + ob + pc * 128 + 16 * mt + 4 * g);
#pragma unroll
    for (int mt = 0; mt < 4; ++mt)
#pragma unroll
      for (int j = 0; j < 4; ++j) {
        int i = 16 * mt + 4 * g + j;
        int r = (cg0 + oc) * 64 + (dir ? 63 - i : i);
        yn[mt * 4 + j] = Y[(long)r * 256 + h * 64 + pc];
      }
    lastn = p.plast[item];
  };
  auto sstore = [&](int st) __attribute__((always_inline)) {
#pragma unroll
    for (int i = 0; i < 4; ++i) {
      const int id = tid + 256 * i, row = id >> 4, ch = id & 15;
      *(u32x4*)(smem + st * STG + row * 272 + ch * 16) = rg[i];
    }
  };
  gload(0);
  sstore(0);
  __syncthreads();
  for (int c = 0; c < n; ++c) {
    const int oc = dir ? n - 1 - c : c;
    u32x2 stc[8]; float yc[16];
#pragma unroll
    for (int mt = 0; mt < 8; ++mt) stc[mt] = stn[mt];
#pragma unroll
    for (int q = 0; q < 16; ++q) yc[q] = yn[q];
    const float el = __expf(lastn);
    if (c + 1 < n) gload(c + 1);
    __builtin_amdgcn_sched_barrier(0);
    const char* sb = smem + (c & 1) * STG + lr * 272 + g * 16;
    bf16x8 bS[4];
#pragma unroll
    for (int ks = 0; ks < 4; ++ks) bS[ks] = pack8(S[2 * ks], S[2 * ks + 1]);
#pragma unroll
    for (int mt = 0; mt < 4; ++mt) {
      f32x4 y = (f32x4){0.f, 0.f, 0.f, 0.f};
#pragma unroll
      for (int ks = 0; ks < 4; ++ks) {
        bf16x8 a = *(const bf16x8*)(sb + mt * 16 * 272 + ks * 64);
        y = mfma(a, bS[ks], y);
      }
#pragma unroll
      for (int j = 0; j < 4; ++j) {
        int i = 16 * mt + 4 * g + j;
        int r = (cg0 + oc) * 64 + (dir ? 63 - i : i);
        Y[(long)r * 256 + h * 64 + pc] = yc[mt * 4 + j] + y[j];
      }
    }
#pragma unroll
    for (int mt = 0; mt < 8; ++mt) {
      S[mt][0] = S[mt][0] * el + lo2f(stc[mt][0]); S[mt][1] = S[mt][1] * el + hi2f(stc[mt][0]);
      S[mt][2] = S[mt][2] * el + lo2f(stc[mt][1]); S[mt][3] = S[mt][3] * el + hi2f(stc[mt][1]);
    }
    __builtin_amdgcn_sched_barrier(0);
    if (c + 1 < n) sstore((c + 1) & 1);
    __syncthreads();
  }
  if (seq < 16) {
    float* so = p.out + O_SS + ((((long)seq * 4 + l) * 2 + dir) * 4 + h) * 8192;
#pragma unroll
    for (int mt = 0; mt < 8; ++mt) *(f32x4*)(so + pc * 128 + 16 * mt + 4 * g) = S[mt];
  }
}

template <bool MLA>
__device__ __forceinline__ void attn_item(const P& p, int l, int seq, int h, int qb, int sub, char* smem) {
  constexpr int KS = MLA ? 3 : 1;
  constexpr int KSTR = MLA ? 208 : 80;
  constexpr int NKC = MLA ? 3 : 1;
  constexpr int KCH = MLA ? 12 : 4;
  constexpr int BUF = 64 * KSTR + 64 * 144;
  const int tid = get_tid(), lane = tid & 63, w = tid >> 6, g = lane >> 4, lr = lane & 15;
  int row0, L, krow0, Lk; long vtbase;
  seq_info(seq, row0, L, krow0, Lk, vtbase);
  const int r0 = row0 + qb * 128 + w * 32;
  const int nkt = Lk >> 6;
  const bf16* vt = (MLA ? p.vtm : p.vtd) + vtbase + (long)h * 64 * Lk;
  bf16x8 bq[KS][2];
#pragma unroll
  for (int nt = 0; nt < 2; ++nt) {
    const int r = r0 + nt * 16 + lr;
    if (MLA) {
      const float sc = 0.10206207261596577f * LOG2E;
#pragma unroll
      for (int ks = 0; ks < KS; ++ks) {
        u32x4 v = *(const u32x4*)(p.qm + (long)r * 384 + h * 96 + ks * 32 + g * 8);
        u32x4 o;
#pragma unroll
        for (int q = 0; q < 4; ++q) o[q] = pack2(lo2f(v[q]) * sc, hi2f(v[q]) * sc);
        bq[ks][nt] = __builtin_bit_cast(bf16x8, o);
      }
    } else {
      bq[0][nt] = *(const bf16x8*)(p.qd + (long)r * 256 + h * 64 + sub * 32 + g * 8);
    }
  }
  f32x4 O[4][2];
  float mx[2], ls[2];
#pragma unroll
  for (int nt = 0; nt < 2; ++nt) {
    mx[nt] = 0.f; ls[nt] = 0.f;
#pragma unroll
    for (int mv = 0; mv < 4; ++mv) O[mv][nt] = (f32x4){0.f, 0.f, 0.f, 0.f};
  }
  u32x4 kreg0[NKC], vreg0[2], kreg1[NKC], vreg1[2];
  auto load_tile = [&](int kt, u32x4 (&kreg)[NKC], u32x4 (&vreg)[2]) __attribute__((always_inline)) {
#pragma unroll
    for (int i = 0; i < NKC; ++i) {
      int id = tid + 256 * i, key = id / KCH, ch = id % KCH;
      long kr = krow0 + kt * 64 + key;
      if (MLA) {
        if (ch < 8) kreg[i] = *(const u32x4*)(p.knope + kr * 256 + h * 64 + ch * 8);
        else kreg[i] = *(const u32x4*)(p.kr + kr * 32 + (ch - 8) * 8);
      } else kreg[i] = *(const u32x4*)(p.kd + kr * 256 + h * 64 + sub * 32 + ch * 8);
    }
#pragma unroll
    for (int i = 0; i < 2; ++i) {
      int id = tid + 256 * i, v = id >> 3, ch = id & 7;
      vreg[i] = *(const u32x4*)(vt + (long)v * Lk + kt * 64 + ch * 8);
    }
  };
  auto store_tile = [&](int b, const u32x4 (&kreg)[NKC], const u32x4 (&vreg)[2]) __attribute__((always_inline)) {
    char* sK = smem + b * BUF; char* sV = sK + 64 * KSTR;
#pragma unroll
    for (int i = 0; i < NKC; ++i) {
      int id = tid + 256 * i, key = id / KCH, ch = id % KCH;
      *(u32x4*)(sK + key * KSTR + ch * 16) = kreg[i];
    }
#pragma unroll
    for (int i = 0; i < 2; ++i) {
      int id = tid + 256 * i, v = id >> 3, ch = id & 7;
      int blk = (ch >> 2) * 32, u0 = 2 * (ch & 3), u1 = u0 + 1;
      int p0 = (u0 < 4) ? 2 * u0 : 2 * (u0 - 4) + 1, p1 = (u1 < 4) ? 2 * u1 : 2 * (u1 - 4) + 1;
      u32x2 a, bb; a[0] = vreg[i][0]; a[1] = vreg[i][1]; bb[0] = vreg[i][2]; bb[1] = vreg[i][3];
      *(u32x2*)(sV + v * 144 + (blk + p0 * 4) * 2) = a;
      *(u32x2*)(sV + v * 144 + (blk + p1 * 4) * 2) = bb;
    }
  };
  auto compute = [&](int cur) __attribute__((always_inline)) {
    const char* sK = smem + cur * BUF; const char* sV = sK + 64 * KSTR;
    f32x4 s[4][2];
    __builtin_amdgcn_s_setprio(1);
#pragma unroll
    for (int mt = 0; mt < 4; ++mt) {
      s[mt][0] = (f32x4){-mx[0], -mx[0], -mx[0], -mx[0]}; s[mt][1] = (f32x4){-mx[1], -mx[1], -mx[1], -mx[1]};
#pragma unroll
      for (int ks = 0; ks < KS; ++ks) {
        bf16x8 aK = *(const bf16x8*)(sK + (mt * 16 + lr) * KSTR + ks * 64 + g * 16);
        s[mt][0] = mfma(aK, bq[ks][0], s[mt][0]);
        s[mt][1] = mfma(aK, bq[ks][1], s[mt][1]);
      }
    }
    __builtin_amdgcn_s_setprio(0);
    float tm[2];
#pragma unroll
    for (int nt = 0; nt < 2; ++nt) {
      float t0 = fmaxf(fmaxf(s[0][nt][0], s[0][nt][1]), fmaxf(s[0][nt][2], s[0][nt][3]));
#pragma unroll
      for (int mt = 1; mt < 4; ++mt) t0 = fmaxf(t0, fmaxf(fmaxf(s[mt][nt][0], s[mt][nt][1]), fmaxf(s[mt][nt][2], s[mt][nt][3])));
      t0 = fmaxf(t0, __shfl_xor(t0, 16));
      t0 = fmaxf(t0, __shfl_xor(t0, 32));
      tm[nt] = t0;
    }
    if (__any((tm[0] > 8.f) || (tm[1] > 8.f))) {
#pragma unroll
      for (int nt = 0; nt < 2; ++nt) {
        const float d = fmaxf(tm[nt], 0.f);
        const float al = ex2(-d);
        mx[nt] += d; ls[nt] *= al;
#pragma unroll
        for (int mv = 0; mv < 4; ++mv)
#pragma unroll
          for (int j = 0; j < 4; ++j) O[mv][nt][j] *= al;
#pragma unroll
        for (int mt = 0; mt < 4; ++mt)
#pragma unroll
          for (int j = 0; j < 4; ++j) s[mt][nt][j] -= d;
      }
    }
    bf16x8 bP[2][2];
#pragma unroll
    for (int nt = 0; nt < 2; ++nt) {
      float su = 0.f;
#pragma unroll
      for (int mt = 0; mt < 4; ++mt)
#pragma unroll
        for (int j = 0; j < 4; ++j) { float e = ex2(s[mt][nt][j]); s[mt][nt][j] = e; su += e; }
      ls[nt] += su;
      bP[0][nt] = pack8(s[0][nt], s[1][nt]);
      bP[1][nt] = pack8(s[2][nt], s[3][nt]);
    }
    __builtin_amdgcn_s_setprio(1);
#pragma unroll
    for (int mv = 0; mv < 4; ++mv)
#pragma unroll
      for (int kb = 0; kb < 2; ++kb) {
        bf16x8 aV = *(const bf16x8*)(sV + (mv * 16 + lr) * 144 + kb * 64 + g * 16);
        O[mv][0] = mfma(aV, bP[kb][0], O[mv][0]);
        O[mv][1] = mfma(aV, bP[kb][1], O[mv][1]);
      }
    __builtin_amdgcn_s_setprio(0);
  };
  load_tile(0, kreg0, vreg0);
  load_tile(1, kreg1, vreg1);
  store_tile(0, kreg0, vreg0);
  __syncthreads();
  for (int kt = 0; kt < nkt; kt += 2) {
    load_tile(min(kt + 2, nkt - 1), kreg0, vreg0);
    __builtin_amdgcn_sched_barrier(0);
    compute(0);
    __builtin_amdgcn_sched_barrier(0);
    store_tile(1, kreg1, vreg1);
    __syncthreads();
    load_tile(min(kt + 3, nkt - 1), kreg1, vreg1);
    __builtin_amdgcn_sched_barrier(0);
    compute(1);
    __builtin_amdgcn_sched_barrier(0);
    store_tile(0, kreg0, vreg0);
    __syncthreads();
  }
#pragma unroll
  for (int nt = 0; nt < 2; ++nt) {
    const int r = r0 + nt * 16 + lr;
    float sm = ls[nt];
    sm += __shfl_xor(sm, 16); sm += __shfl_xor(sm, 32);
    const float inv = 1.f / sm;
    if (MLA) {
#pragma unroll
      for (int mv = 0; mv < 4; ++mv) {
        u32x2 o; o[0] = pack2(O[mv][nt][0] * inv, O[mv][nt][1] * inv);
        o[1] = pack2(O[mv][nt][2] * inv, O[mv][nt][3] * inv);
        *(u32x2*)(p.hbf + (long)r * LDH + 512 + h * 64 + mv * 16 + 4 * g) = o;
      }
    } else {
#pragma unroll
      for (int mv = 0; mv < 4; ++mv) {
        u32x2 o; o[0] = pack2(O[mv][nt][0] * inv, O[mv][nt][1] * inv); o[1] = pack2(O[mv][nt][2] * inv, O[mv][nt][3] * inv);
        *(u32x2*)(p.ao + ((long)sub * NTOK + r) * 256 + h * 64 + mv * 16 + 4 * g) = o;
      }
    }
  }
}

#define P4_ITEMS 1440
__device__ __forceinline__ void p4_item(const P& p, int l, int it, char* smem, int skip_ssd) {
  int kind, a0 = 0, a1 = 0, a2 = 0, a3 = 0;
  if (it < 16) { kind = 0; a0 = 128 + it; }
  else if (it < 32) { kind = 1; a0 = 128 + it - 16; }
  else if (it < 288) { int q = it - 32; kind = 3; a0 = 16 + (q >> 7); a1 = (q >> 5) & 3; a2 = q & 31; }
  else if (it < 800) { int q = it - 288; kind = 2; a3 = q & 1; q >>= 1; a0 = 16 + (q >> 7); a1 = (q >> 5) & 3; a2 = q & 31; }
  else if (it < 928) { kind = 0; a0 = it - 800; }
  else if (it < 1056) { kind = 1; a0 = it - 928; }
  else if (it < 1184) { int q = it - 1056; kind = 3; a0 = q >> 3; a1 = (q >> 1) & 3; a2 = q & 1; }
  else { int q = it - 1184; kind = 2; a3 = q & 1; q >>= 1; a0 = q >> 3; a1 = (q >> 1) & 3; a2 = q & 1; }
  if (kind == 0) dn_chain(p, l, a0, smem);
  else if (kind == 1) { if (!skip_ssd) ssd_chain(p, l, a0, smem); }
  else if (kind == 2) attn_item<false>(p, l, a0, a1, a2, a3, smem);
  else attn_item<true>(p, l, a0, a1, a2, 0, smem);
}

__device__ __forceinline__ void finalize_rows(const P& p, int l, int item) {
  const int tid_ = get_tid(); const int lane = tid_ & 63, w = tid_ >> 6;
  const int r = item * 4 + w;
  const bf16* pr = p.proj + (long)r * NPROJ;
  const int c = lane * 4;
  {
    const float* lp = p.in[13] + l * 128;
    float d0 = 0.f, d1 = 0.f;
    for (int i = 0; i < 32; ++i) { d0 += lp[i] * lp[32 + i]; d1 += lp[64 + i] * lp[96 + i]; }
    const float lam_init = 0.8f - 0.6f * expf(-0.3f * (float)l);
    const float lam = expf(d0) - expf(d1) + lam_init;
    const u32x2 ua = *(const u32x2*)(p.ao + (long)r * 256 + c), ub = *(const u32x2*)(p.ao + ((long)NTOK + r) * 256 + c);
    const f32x4 a = (f32x4){lo2f(ua[0]), hi2f(ua[0]), lo2f(ua[1]), hi2f(ua[1])}, b = (f32x4){lo2f(ub[0]), hi2f(ub[0]), lo2f(ub[1]), hi2f(ub[1])};
    float o[4], ss = 0.f;
#pragma unroll
    for (int j = 0; j < 4; ++j) { o[j] = a[j] - lam * b[j]; ss += o[j] * o[j]; }
    ss += __shfl_xor(ss, 1); ss += __shfl_xor(ss, 2); ss += __shfl_xor(ss, 4); ss += __shfl_xor(ss, 8);
    float rs = rsqrtf(ss * (1.f / 64.f) + EPS_F) * (1.f - lam_init);
    f32x4 gn = *(const f32x4*)(p.in[14] + l * 64 + (c & 63));
    u32x2 out;
    out[0] = pack2(o[0] * rs * gn[0], o[1] * rs * gn[1]);
    out[1] = pack2(o[2] * rs * gn[2], o[3] * rs * gn[3]);
    *(u32x2*)(p.hbf + (long)r * LDH + c) = out;
  }
  {
    const u32x2 ua = *(const u32x2*)(p.of + (long)r * 256 + c), ub = *(const u32x2*)(p.ob + (long)r * 256 + c);
    const f32x4 a = (f32x4){lo2f(ua[0]), hi2f(ua[0]), lo2f(ua[1]), hi2f(ua[1])}, b = (f32x4){lo2f(ub[0]), hi2f(ub[0]), lo2f(ub[1]), hi2f(ub[1])};
    float o[4], ss = 0.f;
#pragma unroll
    for (int j = 0; j < 4; ++j) { o[j] = a[j] + b[j]; ss += o[j] * o[j]; }
    ss += __shfl_xor(ss, 1); ss += __shfl_xor(ss, 2); ss += __shfl_xor(ss, 4); ss += __shfl_xor(ss, 8);
    float rs = rsqrtf(ss * (1.f / 64.f) + EPS_F);
    f32x4 gn = *(const f32x4*)(p.in[18] + l * 64 + (c & 63));
    u32x2 gt = *(const u32x2*)(pr + C_BGATE + c);
    float gv[4] = {lo2f(gt[0]), hi2f(gt[0]), lo2f(gt[1]), hi2f(gt[1])};
    u32x2 out;
    out[0] = pack2(o[0] * rs * gn[0] * siluf(gv[0]), o[1] * rs * gn[1] * siluf(gv[1]));
    out[1] = pack2(o[2] * rs * gn[2] * siluf(gv[2]), o[3] * rs * gn[3] * siluf(gv[3]));
    *(u32x2*)(p.hbf + (long)r * LDH + 256 + c) = out;
  }
  {
    f32x4 a = *(const f32x4*)(p.yf + (long)r * 256 + c), b = *(const f32x4*)(p.yb + (long)r * 256 + c);
    u32x2 xx = *(const u32x2*)(p.sx + (long)r * 256 + c);
    u32x2 zz = *(const u32x2*)(pr + C_DZ + c);
    float xv[4] = {lo2f(xx[0]), hi2f(xx[0]), lo2f(xx[1]), hi2f(xx[1])};
    float zv[4] = {lo2f(zz[0]), hi2f(zz[0]), lo2f(zz[1]), hi2f(zz[1])};
    float dsk = p.in[28][l * 4 + (lane >> 4)];
    float y[4], ss = 0.f;
#pragma unroll
    for (int j = 0; j < 4; ++j) { y[j] = (a[j] + b[j] + dsk * xv[j]) * siluf(zv[j]); ss += y[j] * y[j]; }
    ss += __shfl_xor(ss, 1); ss += __shfl_xor(ss, 2); ss += __shfl_xor(ss, 4); ss += __shfl_xor(ss, 8); ss += __shfl_xor(ss, 16);
    float rs = rsqrtf(ss * (1.f / 128.f) + EPS_F);
    f32x4 gn = *(const f32x4*)(p.in[29] + l * 256 + c);
    u32x2 out;
    out[0] = pack2(y[0] * rs * gn[0], y[1] * rs * gn[1]);
    out[1] = pack2(y[2] * rs * gn[2], y[3] * rs * gn[3]);
    *(u32x2*)(p.hbf + (long)r * LDH + 768 + c) = out;
  }
}

struct EpiProj {
  static constexpr bool STAGED = true;
  bf16* dst; int ld;
  __device__ __forceinline__ f32x4 transform(int r, int c, f32x4 v) const { return v; }
};
struct EpiRes {
  static constexpr bool STAGED = true;
  bf16* dst; int ld;
  const bf16* xb; const float* mod; int gate_idx; int l;
  __device__ __forceinline__ f32x4 transform(int r, int c, f32x4 v) const {
    const int modi = (r < NPROMPT) ? 0 : 1 + ((r - NPROMPT) >> 12);
    const float gt = mod[((long)l * 3 + modi) * 6144 + gate_idx * 1024 + c];
#pragma unroll
    for (int j = 0; j < 4; ++j) v[j] = ALPHA_F * bf2f(xb[(long)(r + j) * 2048 + c]) + gt * v[j];
    return v;
  }
};
struct EpiAct {
  static constexpr bool STAGED = true;
  bf16* dst; int ld;
  __device__ __forceinline__ f32x4 transform(int r, int c, f32x4 v) const {
#pragma unroll
    for (int j = 0; j < 4; ++j) { float x = fmaxf(v[j], 0.f); v[j] = x * x; }
    return v;
  }
};
struct EpiUq {
  static constexpr bool STAGED = true;
  bf16* dst; int ld;
  const P* p;
  __device__ __forceinline__ f32x4 transform(int r, int c, f32x4 v) const {
    const int cc = c % 96;
    const bool ropecol = cc >= 64;
    const int d = (cc - 64) & 31;
    const float sg = ((d >> 3) & 1) ? 1.f : -1.f;
#pragma unroll
    for (int j = 0; j < 4; ++j) {
      float x = v[j];
      float xp = __shfl_xor(x, 8);
      const int rr = r + j;
      if (ropecol && rr >= NPROMPT) {
        float cs, sn; rope_cs(*p, (rr - NPROMPT) & 4095, d, cs, sn);
        x = x * cs + sg * xp * sn;
      }
      v[j] = x;
    }
    return v;
  }
};
struct EpiUkv {
  static constexpr bool STAGED = false;
  const P* p;
  __device__ __forceinline__ void operator()(int r, int c, f32x4 v) const {
    if (c < 256) {
#pragma unroll
      for (int j = 0; j < 4; ++j) p->knope[(long)(r + j) * 256 + c] = f2bf(v[j]);
    } else {
      long base; int key, Lk;
      if (r < NPROMPT) { base = (long)(r >> 8) * 65536; key = r & 255; Lk = 256; }
      else { int rr = r - NPROMPT; int b = rr / 4352; key = rr - b * 4352; Lk = 4352; base = 1048576L + (long)b * (256L * 4352L); }
      u32x2 o; o[0] = pack2(v[0], v[1]); o[1] = pack2(v[2], v[3]);
      *(u32x2*)(p->vtm + base + (long)(c - 256) * Lk + key) = o;
    }
  }
};

__device__ __forceinline__ void xcd_local_barrier(const P& p, const Sched& sc, unsigned* cnt) {
  asm volatile("s_waitcnt vmcnt(0)" ::: "memory");
  __syncthreads();
  if (threadIdx.x == 0) {
    xb_add(cnt, 1u);
    XB_SPIN(xb_ld(cnt) < (unsigned)sc.nloc, p.bar);
  }
  __syncthreads();
}
__device__ __forceinline__ void xcd_ln_then_sync(const P& p, const Sched& sc, int mode, const float* lg, const float* lb, int l,
                                                  int shift_idx, int scale_idx, unsigned* cnt) {
  const int base = sc.xcc * 12 * 16;
  for (int t = sc.rank; t < 192; t += sc.nloc) lnmod_rows(p, base + t, mode, lg, lb, l, shift_idx, scale_idx);
  asm volatile("s_waitcnt vmcnt(0)" ::: "memory");
  __syncthreads();
  if (threadIdx.x == 0) {
    xb_add(cnt, 1u);
    XB_SPIN(xb_ld(cnt) < (unsigned)sc.nloc, p.bar);
  }
  __syncthreads();
}

#define NPHASE 42
__device__ __forceinline__ void run_phase(const P& p, int ph, char* smem, const Sched& sc, int skip_ssd = 0) {
  const int bid = blockIdx.x, nb = gridDim.x;
  if (ph == 0) {
    for (int t = bid; t < 193 + 872; t += nb) {
      if (t < 193) pre_item(p, t, smem);
      else { const int q = t - 193; wconv_item(p, 0, q < WC_IN ? q : q + (WC_OUT + WC_FF1 + WC_FF2), smem); }
    }
    return;
  }
  if (ph == 41) {
    for (int t = bid; t < NTOK / 8; t += nb) lnmod_rows(p, t, 2, p.in[33] + 3 * DM, p.in[34] + 3 * DM, 3, 0, 0);
    return;
  }
  const int l = (ph - 1) / 10, s = (ph - 1) % 10;
  switch (s) {
    case 0: {
      for (int t = bid; t < NTOK / 8; t += nb) {
        if (l == 0) lnmod_rows(p, t, 0, nullptr, nullptr, l, 0, 1);
        else lnmod_rows(p, t, 1, p.in[33] + (l - 1) * DM, p.in[34] + (l - 1) * DM, l, 0, 1);
      }
    } break;
    case 1: {
      EpiProj e{p.proj, NPROJ};
      int mt, nt;
      if (sc.ok) {
        unsigned* cnt = p.bar + XCD_BAR_WORDS + 4096 + ((l * 2 + 0) * 8 + sc.xcc) * 64;
        if (l == 0) xcd_ln_then_sync(p, sc, 0, nullptr, nullptr, l, 0, 1, cnt);
        else xcd_ln_then_sync(p, sc, 1, p.in[33] + (l - 1) * DM, p.in[34] + (l - 1) * DM, l, 0, 1, cnt);
      }
      for (int it = 0; sched_tile(sc, 96, 26, 8, it, mt, nt); ++it) gemm_tile(p.hbf, LDH, p.winT, LDH, DM, mt * 128, nt * 128, smem, e);
      {
        int k = -1;
        if (sc.ok && sc.nloc == 64) { if (sc.rank >= 56 && sc.rank < 60) k = sc.xcc * 4 + (sc.rank - 56); }
        else if (bid < 2 * NT_PAST) k = bid;
        if (k >= 0) { if (k < NT_PAST) prep_diff(p, l, NT_OWN + k); else prep_mla(p, l, NT_OWN + k - NT_PAST); }
      }
    } break;
    case 2: {
      for (int t = bid; t < 4 * NT_OWN; t += nb) {
        if (t < NT_OWN) prep_dn(p, l, t);
        else if (t < 2 * NT_OWN) prep_ssd(p, l, t - NT_OWN);
        else if (t < 3 * NT_OWN) prep_diff(p, l, t - 2 * NT_OWN);
        else prep_mla(p, l, t - 3 * NT_OWN);
      }
    } break;
    case 3: {
      EpiUq eq{p.qm, 384, &p}; EpiUkv ek{&p};
      for (int t = bid; t < 1536 + 1536 + 288 + 400; t += nb) {
        if (t < 1536) dn_chunk_prep(p, t, smem);
        else if (t < 3072) ssd_chunk_prep(p, l, t - 1536, smem);
        else if (t < 3360) { int q = t - 3072; gemm_tile(p.cqn, LDQ, p.wuqT, LDQ, 256, (q / 3) * 128, (q % 3) * 128, smem, eq); }
        else { int q = t - 3360; gemm_tile(p.ckv, LDC, p.wukvT, LDC, 128, (q / 4) * 128, (q % 4) * 128, smem, ek); }
      }
    } break;
    case 4: {
      unsigned* cnt = p.bar + XCD_BAR_WORDS + 1024 + l * 64;
      for (;;) {
        __syncthreads();
        if (threadIdx.x == 0) sc.st[3] = xb_add(cnt, 1u);
        __syncthreads();
        const int it = (int)sc.st[3];
        const int nwc = (l == 0) ? (WC_OUT + WC_FF1) : 0;
        if (it >= P4_ITEMS + nwc) break;
        if (it < P4_ITEMS) p4_item(p, l, it, smem, skip_ssd);
        else wconv_item(p, l, WC_IN + (it - P4_ITEMS), smem);
      }
    } break;
    case 5: {
      if (sc.ok) { for (int t = sc.rank; t < 384; t += sc.nloc) finalize_rows(p, l, sc.xcc * 384 + t); }
      else for (int t = bid; t < NTOK / 4; t += nb) finalize_rows(p, l, t);
    } break;
    case 6: {
      EpiRes e{(bf16*)p.out + 1024, 2048, (const bf16*)p.out, p.mod, 2, l};
      int mt, nt;
      for (int it = 0; sched_tile(sc, 96, 8, 8, it, mt, nt); ++it) gemm_tile(p.hbf, LDH, p.woutT, LDH, DM, mt * 128, nt * 128, smem, e);
      {
        unsigned* cnt = p.bar + XCD_BAR_WORDS + 1024 + 512 + l * 64;
        for (;;) {
          __syncthreads();
          if (threadIdx.x == 0) sc.st[3] = xb_add(cnt, 1u);
          __syncthreads();
          const int q = (int)sc.st[3];
          if (q >= WC_FF2) break;
          wconv_item(p, l, WC_IN + WC_OUT + WC_FF1 + q, smem);
        }
      }
    } break;
    case 7: {
      for (int t = bid; t < NTOK / 8; t += nb) lnmod_rows(p, t, 1, p.in[31] + l * DM, p.in[32] + l * DM, l, 3, 4);
    } break;
    case 8: {
      EpiAct e{p.act, LDACT};
      int mt, nt;
      if (sc.ok) {
        unsigned* cnt = p.bar + XCD_BAR_WORDS + 4096 + ((l * 2 + 1) * 8 + sc.xcc) * 64;
        xcd_ln_then_sync(p, sc, 1, p.in[31] + l * DM, p.in[32] + l * DM, l, 3, 4, cnt);
      }
      for (int it = 0; sched_tile(sc, 96, 32, 8, it, mt, nt); ++it) gemm_tile(p.hbf, LDH, p.wff1T, LDH, DM, mt * 128, nt * 128, smem, e);
    } break;
    case 9: {
      EpiRes e{(bf16*)p.out + 1024, 2048, (const bf16*)p.out, p.mod, 5, l};
      int mt, nt;
      for (int it = 0; sched_tile(sc, 96, 8, 8, it, mt, nt); ++it) gemm_tile(p.act, LDACT, p.wff2T, LDACT, DFF, mt * 128, nt * 128, smem, e);
      if (l < 3) {
        unsigned* cnt = p.bar + XCD_BAR_WORDS + 1024 + 256 + l * 64;
        for (;;) {
          __syncthreads();
          if (threadIdx.x == 0) sc.st[3] = xb_add(cnt, 1u);
          __syncthreads();
          const int q = (int)sc.st[3];
          if (q >= 872 + WC_OUT + WC_FF1) break;
          if (q < 872) wconv_item(p, l + 1, q < WC_IN ? q : q + (WC_OUT + WC_FF1 + WC_FF2), smem);
          else wconv_item(p, l + 1, WC_IN + (q - 872), smem);
        }
      }
    } break;
  }
}

__global__ void __launch_bounds__(NTHR, 2) mega(P p, int ph_lo, int ph_hi, int coop) {
  __shared__ __attribute__((aligned(16))) char smem[SMEM_BYTES];
  __shared__ uint4 xb_words;
  if (threadIdx.x == 0) xb_words = make_uint4(0u, 0u, 0u, 0u);
  __syncthreads();
  XcdBarrier xb;
  xb.bar = p.bar; xb.x = 0; xb.st = (volatile LAS unsigned*)&xb_words;
  Sched sc; sc.xcc = 0; sc.rank = 0; sc.nloc = 1; sc.ok = 0; sc.st = (volatile LAS unsigned*)&xb_words;
  if (coop) {
    xb = xcd_barrier_post(p.bar, (volatile LAS unsigned*)&xb_words);
    if (threadIdx.x == 0) xb_words.z = xb_add(&p.bar[XCD_BAR_WORDS + 64 * xb.x], 1u);
    __syncthreads();
    sc.xcc = (int)xb.x; sc.rank = (int)((volatile LAS unsigned*)&xb_words)[2];
  }
  if (ph_hi > 1000) cg::this_grid().sync();
#define GRID_SYNC() xcd_barrier(xb)
  for (int ph = ph_lo; ph < ph_hi; ++ph) {
    if (coop && ph > ph_lo) {
      const unsigned nl = ((volatile LAS unsigned*)&xb_words)[0], nxx = ((volatile LAS unsigned*)&xb_words)[1];
      if (ph == ph_lo + 1) {
        unsigned hi = 0u;
#pragma unroll
        for (int j = 8; j < 16; ++j) hi |= xb_ld(&p.bar[XB_XCNT(j)]);
        sc.ok = (nxx == 8u && hi == 0u && nl > 0u) ? 1 : 0;
      }
      sc.nloc = (int)nl;
    }
    if (sc.ok && ph >= 1 && ph <= 40 && (((ph - 1) % 10) == 0 || ((ph - 1) % 10) == 7)) continue;
    run_phase(p, ph, smem, sc);
    if (coop && ph + 1 < ph_hi) {
      const int sph = (ph >= 1 && ph <= 40) ? (ph - 1) % 10 : -1;
      if (sc.ok && (sph == 5 || sph == 6)) xcd_local_barrier(p, sc, p.bar + XCD_BAR_WORDS + 8192 + ((((ph - 1) / 10) * 2 + (sph - 5)) * 8 + sc.xcc) * 64);
      else GRID_SYNC();
    }
#if (PROBE_MASK >> 10) & 1
    GRID_SYNC(); GRID_SYNC();
#endif
#if PROBE_MASK
    if (ph >= 1 && ph <= 40) {
      const int s = (ph - 1) % 10;
      if (((PROBE_MASK >> s) & 1) && s != 4) { run_phase(p, ph, smem, sc); GRID_SYNC(); }
    }
#endif
  }
}

static size_t align_up(size_t x) { return (x + 255) & ~(size_t)255; }

extern "C" void kernel_launch(void* const* d_in, const int* in_sizes, int n_in, void* d_out, int out_size, void* d_ws,
                              size_t ws_size, hipStream_t stream) {
  static int grid_blocks = 0;
  if (!grid_blocks) {
    int dev = 0, cus = 0, per_cu = 0;
    hipGetDevice(&dev);
    hipDeviceGetAttribute(&cus, hipDeviceAttributeMultiprocessorCount, dev);
    hipOccupancyMaxActiveBlocksPerMultiprocessor(&per_cu, mega, NTHR, 0);
    if (per_cu < 1) per_cu = 1;
    if (per_cu > 2) per_cu = 2;
    grid_blocks = cus * per_cu;
  }
  P p;
  memset(&p, 0, sizeof(p));
  for (int i = 0; i < 37; ++i) p.in[i] = (const float*)d_in[i];
  p.out = (float*)d_out;
  char* ws = (char*)d_ws;
  size_t off = 0;
  auto take = [&](size_t bytes) { char* q = ws + off; off = align_up(off + bytes); return q; };
  p.winT = (bf16*)take((size_t)NPROJ * LDH * 2);
  p.woutT = (bf16*)take((size_t)1024 * LDH * 2);
  p.wff1T = (bf16*)take((size_t)4096 * LDH * 2);
  p.wff2T = (bf16*)take((size_t)1024 * LDACT * 2);
  p.wuqT = (bf16*)take((size_t)384 * LDQ * 2);
  p.wukvT = (bf16*)take((size_t)512 * LDC * 2);
  p.mod = (float*)take((size_t)4 * 3 * 6144 * 4);
  p.ropeC = (float*)take(512 * 4);
  p.ropeS = (float*)take(512 * 4);
  p.hbf = (bf16*)take((size_t)NTOK * LDH * 2);
  size_t r1 = off;
  p.proj = (bf16*)take((size_t)NTOK * NPROJ * 2);
  p.qd = (bf16*)take((size_t)NTOK * 256 * 2);
  p.kd = (bf16*)take((size_t)NKROW * 256 * 2);
  p.vtd = (bf16*)take((size_t)3276800 * 2);
  p.cqn = (bf16*)take((size_t)NTOK * LDQ * 2);
  p.qm = (bf16*)take((size_t)NTOK * 384 * 2);
  p.ckv = (bf16*)take((size_t)NKROW * LDC * 2);
  p.kr = (bf16*)take((size_t)NKROW * 32 * 2);
  p.knope = (bf16*)take((size_t)NKROW * 256 * 2);
  p.vtm = (bf16*)take((size_t)3276800 * 2);
  size_t r2 = off;
  p.dq = (bf16*)take((size_t)NTOK * 256 * 2);
  p.dk = (bf16*)take((size_t)NTOK * 256 * 2);
  p.dv = (bf16*)take((size_t)NTOK * 256 * 2);
  p.dbeta = (float*)take((size_t)NTOK * 8 * 4);
  p.dg = (float*)take((size_t)NTOK * 8 * 4);
  p.sb = (bf16*)take((size_t)NTOK * 256 * 2);
  p.sc = (bf16*)take((size_t)NTOK * 256 * 2);
  if (off - r2 < (size_t)2 * NTOK * 256 * 4) off = r2 + (size_t)2 * NTOK * 256 * 4;
  p.ao = (bf16*)(ws + r2);
  p.sx = (bf16*)take((size_t)NTOK * 256 * 2);
  p.sdt = (float*)take((size_t)NTOK * 8 * 4);
  p.pu = (bf16*)take((size_t)1536 * 4096 * 2);
  p.pw = (bf16*)take((size_t)1536 * 4096 * 2);
  p.pqd = (bf16*)take((size_t)1536 * 4096 * 2);
  p.pqk = (bf16*)take((size_t)1536 * 4096 * 2);
  p.pkd = (bf16*)take((size_t)1536 * 4096 * 2);
  p.pgl = (float*)take(1536 * 4);
  p.pst = (bf16*)take((size_t)1536 * 8192 * 2);
  p.pcd = (bf16*)take((size_t)1536 * 8192 * 2);
  p.plast = (float*)take(1536 * 4);
  p.of = (bf16*)take((size_t)NTOK * 256 * 2);
  p.ob = (bf16*)take((size_t)NTOK * 256 * 2);
  p.yf = (float*)take((size_t)NTOK * 256 * 4);
  p.yb = (float*)take((size_t)NTOK * 256 * 4);
  p.bar = (unsigned*)take((size_t)(XCD_BAR_WORDS + 8192 + 4096) * 4);
  p.act = (bf16*)(ws + r1);
  size_t need = off;
  if (r1 + (size_t)NTOK * LDACT * 2 > need) need = r1 + (size_t)NTOK * LDACT * 2;
  if (need > ws_size) { fprintf(stderr, "kernel_launch: workspace too small: need %zu have %zu\n", need, ws_size); return; }
  hipMemsetAsync(p.bar, 0, (size_t)(XCD_BAR_WORDS + 8192 + 4096) * 4, stream);
#if MULTI_LAUNCH
  for (int ph = 0; ph < NPHASE; ++ph) {
    hipLaunchKernelGGL(mega, dim3(grid_blocks), dim3(NTHR), 0, stream, p, ph, ph + 1, 0);
  }
#else
  int lo = 0, hi = NPHASE, coop = 1;
  void* args[] = {&p, &lo, &hi, &coop};
  hipError_t e = hipLaunchCooperativeKernel((void*)mega, dim3(grid_blocks), dim3(NTHR), args, 0, stream);
  if (e != hipSuccess) fprintf(stderr, "cooperative launch failed: %s (grid %d)\n", hipGetErrorString(e), grid_blocks);
#endif
}
```

```cpp
#include <hip/hip_runtime.h>
#include <hip/hip_cooperative_groups.h>
#include <cstdio>
#include <cstring>
namespace cg = cooperative_groups;

#ifndef PROBE_MASK
#define PROBE_MASK 0
#endif
#ifndef MULTI_LAUNCH
#define MULTI_LAUNCH 0
#endif

typedef unsigned short bf16;
typedef short bf16x8 __attribute__((ext_vector_type(8)));
typedef float f32x4 __attribute__((ext_vector_type(4)));
typedef unsigned u32x4 __attribute__((ext_vector_type(4)));
typedef unsigned u32x2 __attribute__((ext_vector_type(2)));

#define NTHR 256
#define NTOK 12288
#define NPROMPT 4096
#define NKROW 12800
#define DM 1024
#define NPROJ 3328
#define DFF 4096
#define KPAD 64
#define LDH (DM + KPAD)
#define LDACT (DFF + KPAD)
#define LDQ (256 + KPAD)
#define LDC (128 + KPAD)
#define SMEM_BYTES 73728
#define ALPHA_F 1.681792830507429f
#define EPS_F 1e-6f
#define LOG2E 1.4426950408889634f

#define C_AQ 0
#define C_AK 256
#define C_AV 512
#define C_BQKV 768
#define C_BBETA 1536
#define C_BDECAY 1544
#define C_BGATE 1552
#define C_CQ 1808
#define C_CKV 2064
#define C_CKR 2192
#define C_DZ 2224
#define C_DXBC 2480
#define C_DDT 3248

#define O_Y 0
#define O_DK 12582912
#define O_DV 16777216
#define O_SD 20971520
#define O_CKV 23068672
#define O_KR 25165824
#define O_SS 25690112

struct P {
  const float* in[37];
  float* out;
  bf16 *winT, *woutT, *wff1T, *wff2T, *wuqT, *wukvT;
  float *mod, *ropeC, *ropeS;
  bf16 *hbf, *proj, *act;
  bf16 *qd, *kd, *vtd, *cqn, *qm, *ckv, *kr, *knope, *vtm;
  bf16 *dq, *dk, *dv; float *dbeta, *dg;
  bf16 *sx, *sb, *sc; float *sdt;
  bf16 *pu, *pw, *pqd, *pqk, *pkd; float *pgl;
  bf16 *pst, *pcd; float *plast;
  bf16 *of, *ob, *ao; float *yf, *yb;
  unsigned* bar;
};

typedef __bf16 hbf16x2 __attribute__((ext_vector_type(2)));
typedef float f32x2 __attribute__((ext_vector_type(2)));
__device__ __forceinline__ bf16 f2bf(float f) { __bf16 h = (__bf16)f; return __builtin_bit_cast(bf16, h); }
__device__ __forceinline__ float bf2f(bf16 h) { return __uint_as_float(((unsigned)h) << 16); }
__device__ __forceinline__ unsigned pack2(float a, float b) { f32x2 v = {a, b}; return __builtin_bit_cast(unsigned, __builtin_convertvector(v, hbf16x2)); }
__device__ __forceinline__ float lo2f(unsigned u) { return __uint_as_float(u << 16); }
__device__ __forceinline__ float hi2f(unsigned u) { return __uint_as_float(u & 0xffff0000u); }
__device__ __forceinline__ bf16x8 pack8(f32x4 a, f32x4 b) {
  u32x4 r; r[0] = pack2(a[0], a[1]); r[1] = pack2(a[2], a[3]); r[2] = pack2(b[0], b[1]); r[3] = pack2(b[2], b[3]);
  return __builtin_bit_cast(bf16x8, r);
}
__device__ __forceinline__ f32x4 mfma(bf16x8 a, bf16x8 b, f32x4 c) { return __builtin_amdgcn_mfma_f32_16x16x32_bf16(a, b, c, 0, 0, 0); }
__device__ __forceinline__ float ex2(float x) { return __builtin_amdgcn_exp2f(x); }
__device__ __forceinline__ float siluf(float x) { return x / (1.f + __expf(-x)); }
__device__ __forceinline__ float sigmoidf_(float x) { return 1.f / (1.f + __expf(-x)); }
__device__ __forceinline__ float softplusf_(float x) { return x > 20.f ? x : log1pf(__expf(x)); }
__device__ __forceinline__ int get_tid() { int t = threadIdx.x; asm volatile("" : "+v"(t)); return t; }
__device__ __forceinline__ float wave_sum(float v) {
#pragma unroll
  for (int o = 32; o >= 1; o >>= 1) v += __shfl_xor(v, o);
  return v;
}
__device__ __forceinline__ int permk(int k) { int kk = k & 31; return (k & ~31) + 8 * ((kk & 15) >> 2) + (kk & 3) + ((kk >> 4) << 2); }

__device__ __forceinline__ void tok_info(int r, int& seq, int& pos, int& L, int& krow, int& modi) {
  if (r < NPROMPT) { seq = r >> 8; pos = r & 255; L = 256; krow = r; modi = 0; }
  else { int rr = r - NPROMPT; int b = rr >> 12; seq = 16 + b; pos = rr & 4095; L = 4096; krow = NPROMPT + b * 4352 + pos; modi = 1 + b; }
}
__device__ __forceinline__ void seq_info(int seq, int& row0, int& L, int& krow0, int& Lk, long& vtbase) {
  if (seq < 16) { row0 = seq * 256; L = 256; krow0 = row0; Lk = 256; vtbase = (long)seq * 65536; }
  else { int b = seq - 16; row0 = NPROMPT + b * 4096; L = 4096; krow0 = NPROMPT + b * 4352; Lk = 4352; vtbase = 1048576L + (long)b * (256L * 4352L); }
}


#define XB_TMO      128
#define XB_XCNT(j)  (256  + 64 * (j))
#define XB_XSUB(j)  (1280 + 64 * (j))
#define XB_XGEN(j)  (2304 + 64 * (j))
#define XB_TOP      3328
#define XB_TOPGEN   3392
#define XCD_BAR_WORDS 3456
#define XB_SPIN_CAP (1u << 20)
#define LAS __attribute__((address_space(3)))
__device__ __forceinline__ unsigned xb_ld(unsigned* p)              { return __hip_atomic_load(p, __ATOMIC_RELAXED, __HIP_MEMORY_SCOPE_AGENT); }
__device__ __forceinline__ unsigned xb_add(unsigned* p, unsigned v) { return __hip_atomic_fetch_add(p, v, __ATOMIC_RELAXED, __HIP_MEMORY_SCOPE_AGENT); }
__device__ __forceinline__ unsigned xb_xcc_id() { return (unsigned)__builtin_amdgcn_s_getreg((3 << 11) | 20) & 0xFu; }
#define XB_SPIN(cond, bar) do { unsigned _sp = 0; while (cond) { __builtin_amdgcn_s_sleep(1); \
    if ((++_sp & 255u) == 0u) { if (xb_ld(&(bar)[XB_TMO])) break; if (_sp > XB_SPIN_CAP) { atomicAdd(&(bar)[XB_TMO], 1u); break; } } } } while (0)
struct XcdBarrier { unsigned* bar; unsigned x; volatile LAS unsigned* st; };
__device__ __forceinline__ XcdBarrier xcd_barrier_post(unsigned* bar, volatile LAS unsigned* st) {
  XcdBarrier b; b.bar = bar; b.x = xb_xcc_id(); b.st = st;
  if (threadIdx.x == 0) (void)xb_add(&bar[XB_XCNT(b.x)], 1u);
  return b;
}
__device__ __forceinline__ void xcd_barrier_complete(unsigned* bar, unsigned x, unsigned& nloc, unsigned& nx) {
  const unsigned G = gridDim.x * gridDim.y * gridDim.z;
  unsigned sum, cnt, mine, sp = 0u;
  for (;;) {
    sum = 0u; cnt = 0u; mine = 0u;
#pragma unroll
    for (unsigned j = 0; j < 16; ++j) { const unsigned c = xb_ld(&bar[XB_XCNT(j)]); sum += c; cnt += (c > 0u) ? 1u : 0u; mine = (j == x) ? c : mine; }
    if (sum == G) break;
    __builtin_amdgcn_s_sleep(1);
    if ((++sp & 255u) == 0u) { if (xb_ld(&bar[XB_TMO])) break; if (sp > XB_SPIN_CAP) { atomicAdd(&bar[XB_TMO], 1u); break; } }
  }
  nloc = mine > 0u ? mine : 1u; nx = cnt > 0u ? cnt : 1u;
}
__device__ __forceinline__ void xcd_barrier(const XcdBarrier& b) {
  asm volatile("s_waitcnt vmcnt(0)" ::: "memory");
  __syncthreads();
  if (threadIdx.x == 0) {
    unsigned* bar = b.bar;
    __builtin_amdgcn_s_waitcnt(0);
    unsigned nloc = b.st[0], nx = b.st[1];
    if (nloc == 0u) { xcd_barrier_complete(bar, b.x, nloc, nx); b.st[0] = nloc; b.st[1] = nx; }
    const unsigned old = xb_add(&bar[XB_XSUB(b.x)], 1u);
    const unsigned gen = old / nloc;
    if (old + 1u == (gen + 1u) * nloc) {
      __builtin_amdgcn_fence(__ATOMIC_RELEASE, "agent");
      asm volatile("s_waitcnt vmcnt(0)" ::: "memory");
      const unsigned og = xb_add(&bar[XB_TOP], 1u);
      const unsigned tg = og / nx;
      if (og + 1u == (tg + 1u) * nx) xb_add(&bar[XB_TOPGEN], 1u);
      else XB_SPIN(xb_ld(&bar[XB_TOPGEN]) == tg, bar);
      __builtin_amdgcn_fence(__ATOMIC_ACQUIRE, "agent");
      xb_add(&bar[XB_XGEN(b.x)], 1u);
      asm volatile("s_waitcnt vmcnt(0)" ::: "memory");
    } else {
      XB_SPIN(xb_ld(&bar[XB_XGEN(b.x)]) == gen, bar);
      __builtin_amdgcn_fence(__ATOMIC_ACQUIRE, "agent");
      asm volatile("s_waitcnt vmcnt(0)" ::: "memory");
    }
  }
  __syncthreads();
}

#define GSTR 144
template <class Epi>
__device__ __forceinline__ void gemm_tile(const bf16* __restrict__ A, int lda, const bf16* __restrict__ Bt, int ldb, int K,
                                          int m0, int n0, char* smem, Epi epi) {
  const int tid = get_tid(), lane = tid & 63, w = tid >> 6, g = lane >> 4, lr = lane & 15;
  const int wm = w >> 1, wn = w & 1;
  constexpr int GT = 128 * 128;
  constexpr int GBUF = 2 * GT;
  f32x4 acc[4][4];
#pragma unroll
  for (int i = 0; i < 4; ++i)
#pragma unroll
    for (int j = 0; j < 4; ++j) acc[i][j] = (f32x4){0.f, 0.f, 0.f, 0.f};
  const int nk = K >> 6;
  const int srow = 8 * w + (lane >> 3);
  const int spc = (lane & 7) ^ ((srow >> 1) & 7);
  const bf16* Ag = A + (long)(m0 + srow) * lda + spc * 8;
  const bf16* Bg = Bt + (long)(n0 + srow) * ldb + spc * 8;
  const long a32 = (long)32 * lda, b32 = (long)32 * ldb;
  typedef __attribute__((address_space(3))) unsigned lds_u32;
#define G_ISSUE(BUF, KT) { _Pragma("unroll") for (int i = 0; i < 4; ++i) { \
    __builtin_amdgcn_global_load_lds((const unsigned*)(Ag + i * a32 + (KT) * 64), (lds_u32*)(smem + (BUF) * GBUF + (i * 4 + w) * 1024), 16, 0, 0); \
    __builtin_amdgcn_global_load_lds((const unsigned*)(Bg + i * b32 + (KT) * 64), (lds_u32*)(smem + (BUF) * GBUF + GT + (i * 4 + w) * 1024), 16, 0, 0); } }
  const int sw = (lr >> 1) & 7;
  G_ISSUE(0, 0);
  asm volatile("s_waitcnt vmcnt(0)" ::: "memory");
  __syncthreads();
  for (int kt = 0; kt < nk; ++kt) {
    const int cur = kt & 1;
    if (kt + 1 < nk) G_ISSUE(cur ^ 1, kt + 1);
    bf16x8 a[2][4], b[2][4];
#pragma unroll
    for (int ks = 0; ks < 2; ++ks) {
      const int pc = ((ks * 4 + g) ^ sw) * 16;
#pragma unroll
      for (int i = 0; i < 4; ++i) {
        a[ks][i] = *(const bf16x8*)(smem + cur * GBUF + (wm * 64 + i * 16 + lr) * 128 + pc);
        b[ks][i] = *(const bf16x8*)(smem + cur * GBUF + GT + (wn * 64 + i * 16 + lr) * 128 + pc);
      }
    }
    __builtin_amdgcn_sched_barrier(0);
#pragma unroll
    for (int ks = 0; ks < 2; ++ks)
#pragma unroll
      for (int i = 0; i < 4; ++i)
#pragma unroll
        for (int j = 0; j < 4; ++j) acc[i][j] = mfma(a[ks][i], b[ks][j], acc[i][j]);
    __builtin_amdgcn_sched_barrier(0);
    asm volatile("s_waitcnt vmcnt(0)" ::: "memory");
    __syncthreads();
  }
#undef G_ISSUE
  if constexpr (Epi::STAGED) {
    char* sC = smem + w * 9216;
#pragma unroll
    for (int i = 0; i < 4; ++i)
#pragma unroll
      for (int j = 0; j < 4; ++j) {
        f32x4 v = epi.transform(m0 + wm * 64 + i * 16 + g * 4, n0 + wn * 64 + j * 16 + lr, acc[i][j]);
#pragma unroll
        for (int q = 0; q < 4; ++q) *(bf16*)(sC + (i * 16 + g * 4 + q) * GSTR + (j * 16 + lr) * 2) = f2bf(v[q]);
      }
#pragma unroll
    for (int q = 0; q < 8; ++q) {
      int id = lane + 64 * q, row = id >> 3, ch = id & 7;
      u32x4 v = *(const u32x4*)(sC + row * GSTR + ch * 16);
      *(u32x4*)(epi.dst + (long)(m0 + wm * 64 + row) * epi.ld + n0 + wn * 64 + ch * 8) = v;
    }
    __syncthreads();
  } else {
#pragma unroll
    for (int i = 0; i < 4; ++i)
#pragma unroll
      for (int j = 0; j < 4; ++j) epi(m0 + wm * 64 + i * 16 + g * 4, n0 + wn * 64 + j * 16 + lr, acc[i][j]);
  }
}

struct Sched { int xcc, rank, nloc, ok; volatile __attribute__((address_space(3))) unsigned* st; };
__device__ __forceinline__ bool sched_tile(const Sched& sc, int MT, int NT, int PW, int iter, int& mt, int& nt) {
  if (!sc.ok) {
    int t = blockIdx.x + iter * gridDim.x;
    if (t >= MT * NT) return false;
    mt = t / NT; nt = t % NT; return true;
  }
  const int m_lo = (sc.xcc * MT) >> 3, m_hi = ((sc.xcc + 1) * MT) >> 3, Mr = m_hi - m_lo;
  int q = sc.rank + iter * sc.nloc;
  if (q >= Mr * NT) return false;
  const int per = Mr * PW, nfull = NT / PW;
  int pnl = q / per, w = PW;
  if (pnl >= nfull) { pnl = nfull; w = NT - nfull * PW; }
  const int within = q - pnl * per;
  mt = m_lo + within / w; nt = pnl * PW + within % w;
  return true;
}

__device__ __forceinline__ void pre_item(const P& p, int item, char* smem) {
  const int tid = get_tid();
  if (item == 192) {
    for (int i = tid; i < 512; i += NTHR) {
      int pos = i >> 3, f = i & 7;
      float inv = expf(-(float)f * 0.125f * 9.210340371976184f);
      float s, c; sincosf((float)pos * inv, &s, &c);
      p.ropeC[i] = c; p.ropeS[i] = s;
    }
    return;
  }
  const int l = item / 48, cgp = item % 48, c0 = cgp * 128;
  float* sv = (float*)smem;
  float* red = (float*)(smem + 12288);
  for (int i = tid; i < 3072; i += NTHR) {
    int m = i >> 10, k = i & 1023;
    float x = (m == 0) ? p.in[9][k] : p.in[8][(m - 1) * 1024 + k];
    sv[i] = siluf(x);
  }
  __syncthreads();
  const int cl = tid & 31, ksub = tid >> 5;
  float acc[3][4];
#pragma unroll
  for (int m = 0; m < 3; ++m)
#pragma unroll
    for (int j = 0; j < 4; ++j) acc[m][j] = 0.f;
  const float* wp = p.in[10] + (long)l * 1024 * 6144 + c0 + cl * 4;
#pragma unroll 4
  for (int k = ksub; k < 1024; k += 8) {
    f32x4 w4 = __builtin_nontemporal_load((const f32x4*)(wp + (long)k * 6144));
    float s0 = sv[k], s1 = sv[1024 + k], s2 = sv[2048 + k];
#pragma unroll
    for (int j = 0; j < 4; ++j) { acc[0][j] += s0 * w4[j]; acc[1][j] += s1 * w4[j]; acc[2][j] += s2 * w4[j]; }
  }
#pragma unroll
  for (int m = 0; m < 3; ++m)
#pragma unroll
    for (int j = 0; j < 4; ++j) red[(ksub * 3 + m) * 128 + cl * 4 + j] = acc[m][j];
  __syncthreads();
  for (int i = tid; i < 384; i += NTHR) {
    int m = i >> 7, c = i & 127;
    float s = 0.f;
#pragma unroll
    for (int q = 0; q < 8; ++q) s += red[(q * 3 + m) * 128 + c];
    p.mod[((long)l * 3 + m) * 6144 + c0 + c] = s + p.in[11][l * 6144 + c0 + c];
  }
  __syncthreads();
}

__device__ __forceinline__ void wconv_tile(const float* __restrict__ W, int K, int N, bf16* __restrict__ Wt, int kt, int nt, char* smem) {
  float* T = (float*)smem;
  const int tid = get_tid();
  {
    int kk = tid >> 2, cc = (tid & 3) * 16;
#pragma unroll
    for (int q = 0; q < 4; ++q) {
      int n = nt * 64 + cc + q * 4;
      f32x4 v = (f32x4){0.f, 0.f, 0.f, 0.f};
      if (n < N) v = __builtin_nontemporal_load((const f32x4*)(W + (long)(kt * 64 + kk) * N + n));
#pragma unroll
      for (int j = 0; j < 4; ++j) T[kk * 65 + cc + q * 4 + j] = v[j];
    }
  }
  __syncthreads();
  {
    int n = tid >> 2, kc = (tid & 3) * 16;
    u32x4 o0, o1;
#pragma unroll
    for (int q = 0; q < 4; ++q) {
      o0[q] = pack2(T[(kc + 2 * q) * 65 + n], T[(kc + 2 * q + 1) * 65 + n]);
      o1[q] = pack2(T[(kc + 8 + 2 * q) * 65 + n], T[(kc + 8 + 2 * q + 1) * 65 + n]);
    }
    bf16* dst = Wt + (long)(nt * 64 + n) * (K + KPAD) + kt * 64 + kc;
    *(u32x4*)dst = o0;
    *(u32x4*)(dst + 8) = o1;
  }
  __syncthreads();
}

#define WC_IN 832
#define WC_OUT 256
#define WC_FF1 1024
#define WC_FF2 1024
#define WC_UQ 24
#define WC_UK 8
#define WC_UV 8
#define WC_TOTAL (WC_IN + WC_OUT + WC_FF1 + WC_FF2 + WC_UQ + WC_UK + WC_UV)

__device__ __forceinline__ void wconv_item(const P& p, int l, int it, char* smem) {
  const float* W; int K, N, ntn; bf16* Wt;
  if (it < WC_IN) { W = p.in[12] + (long)l * 1024 * 3256; K = 1024; N = 3256; Wt = p.winT; ntn = 52; }
  else if ((it -= WC_IN) < WC_OUT) { W = p.in[30] + (long)l * 1024 * 1024; K = 1024; N = 1024; Wt = p.woutT; ntn = 16; }
  else if ((it -= WC_OUT) < WC_FF1) { W = p.in[35] + (long)l * 1024 * 4096; K = 1024; N = 4096; Wt = p.wff1T; ntn = 64; }
  else if ((it -= WC_FF1) < WC_FF2) { W = p.in[36] + (long)l * 4096 * 1024; K = 4096; N = 1024; Wt = p.wff2T; ntn = 16; }
  else if ((it -= WC_FF2) < WC_UQ) { W = p.in[21] + (long)l * 256 * 384; K = 256; N = 384; Wt = p.wuqT; ntn = 6; }
  else if ((it -= WC_UQ) < WC_UK) { W = p.in[22] + (long)l * 128 * 256; K = 128; N = 256; Wt = p.wukvT; ntn = 4; }
  else { it -= WC_UK; W = p.in[23] + (long)l * 128 * 256; K = 128; N = 256; Wt = p.wukvT + 256 * LDC; ntn = 4; }
  wconv_tile(W, K, N, Wt, it / ntn, it % ntn, smem);
}

__device__ __forceinline__ void lnmod_rows(const P& p, int item, int mode, const float* lg, const float* lb, int l, int shift_idx, int scale_idx) {
  constexpr int LNR = 2;
  const int tid_ = get_tid(); const int lane = tid_ & 63, w = tid_ >> 6;
  const int rbase = item * (4 * LNR) + w * LNR;
  f32x4 v[LNR][4];
  if (mode == 0) {
#pragma unroll
    for (int q = 0; q < LNR; ++q) {
      const int r = rbase + q;
      const float* src = (r < NPROMPT) ? (p.in[0] + (long)r * DM) : (p.in[1] + (long)(r - NPROMPT) * DM);
#pragma unroll
      for (int i = 0; i < 4; ++i) v[q][i] = *(const f32x4*)(src + lane * 4 + 256 * i);
    }
  } else {
    u32x2 u[LNR][4];
#pragma unroll
    for (int q = 0; q < LNR; ++q)
#pragma unroll
      for (int i = 0; i < 4; ++i) u[q][i] = *(const u32x2*)((const bf16*)p.out + (long)(rbase + q) * 2048 + 1024 + lane * 4 + 256 * i);
    f32x4 gg[4], bb[4];
#pragma unroll
    for (int i = 0; i < 4; ++i) { gg[i] = *(const f32x4*)(lg + lane * 4 + 256 * i); bb[i] = *(const f32x4*)(lb + lane * 4 + 256 * i); }
#pragma unroll
    for (int q = 0; q < LNR; ++q) {
#pragma unroll
      for (int i = 0; i < 4; ++i) { v[q][i][0] = lo2f(u[q][i][0]); v[q][i][1] = hi2f(u[q][i][0]); v[q][i][2] = lo2f(u[q][i][1]); v[q][i][3] = hi2f(u[q][i][1]); }
      float s = 0.f;
#pragma unroll
      for (int i = 0; i < 4; ++i) s += v[q][i][0] + v[q][i][1] + v[q][i][2] + v[q][i][3];
      s = wave_sum(s);
      const float mu = s * (1.f / 1024.f);
      float qq = 0.f;
#pragma unroll
      for (int i = 0; i < 4; ++i)
#pragma unroll
        for (int j = 0; j < 4; ++j) { float d = v[q][i][j] - mu; qq += d * d; }
      qq = wave_sum(qq);
      const float rs = rsqrtf(qq * (1.f / 1024.f) + EPS_F);
#pragma unroll
      for (int i = 0; i < 4; ++i)
#pragma unroll
        for (int j = 0; j < 4; ++j) v[q][i][j] = (v[q][i][j] - mu) * rs * gg[i][j] + bb[i][j];
    }
  }
  if (mode == 2) {
#pragma unroll
    for (int q = 0; q < LNR; ++q)
#pragma unroll
      for (int i = 0; i < 4; ++i) *(f32x4*)(p.out + (long)(rbase + q) * DM + lane * 4 + 256 * i) = v[q][i];
    return;
  }
  const int modi = (rbase < NPROMPT) ? 0 : 1 + ((rbase - NPROMPT) >> 12);
  const float* md = p.mod + ((long)l * 3 + modi) * 6144;
  f32x4 sh[4], scl[4];
#pragma unroll
  for (int i = 0; i < 4; ++i) { sh[i] = *(const f32x4*)(md + shift_idx * 1024 + lane * 4 + 256 * i); scl[i] = *(const f32x4*)(md + scale_idx * 1024 + lane * 4 + 256 * i); }
#pragma unroll
  for (int q = 0; q < LNR; ++q) {
    const int r = rbase + q;
    bf16* rowb = (bf16*)p.out + (long)r * 2048;
#pragma unroll
    for (int i = 0; i < 4; ++i) {
      u32x2 o; o[0] = pack2(v[q][i][0], v[q][i][1]); o[1] = pack2(v[q][i][2], v[q][i][3]);
      *(u32x2*)(rowb + lane * 4 + 256 * i) = o;
      u32x2 h;
      h[0] = pack2(v[q][i][0] * (1.f + scl[i][0]) + sh[i][0], v[q][i][1] * (1.f + scl[i][1]) + sh[i][1]);
      h[1] = pack2(v[q][i][2] * (1.f + scl[i][2]) + sh[i][2], v[q][i][3] * (1.f + scl[i][3]) + sh[i][3]);
      *(u32x2*)(p.hbf + (long)r * LDH + lane * 4 + 256 * i) = h;
    }
  }
}

__device__ __forceinline__ void rope_cs(const P& p, int pos, int d, float& c, float& s) {
  int q = d >> 3, f = d & 7;
  int pp = (q < 2) ? (pos >> 6) : (pos & 63);
  c = p.ropeC[pp * 8 + f]; s = p.ropeS[pp * 8 + f];
}

#define PT 32
#define NT_OWN (NTOK / PT)
#define NT_PAST (512 / PT)
__device__ __forceinline__ void prep_diff(const P& p, int l, int tile) {
  const int tid = get_tid();
  const bool past = tile >= NT_OWN;
  int r0 = 0, seq, pos0, L, krow0, modi;
  const float* ck = nullptr; const float* cv = nullptr;
  if (!past) { r0 = tile * PT; tok_info(r0, seq, pos0, L, krow0, modi); }
  else {
    int b = (tile - NT_OWN) / (256 / PT), j0 = ((tile - NT_OWN) % (256 / PT)) * PT;
    seq = 16 + b; pos0 = 4096 + j0; krow0 = NPROMPT + b * 4352 + 4096 + j0;
    ck = p.in[2] + ((long)(b * 4 + l) * 256 + j0) * 256;
    cv = p.in[3] + ((long)(b * 4 + l) * 256 + j0) * 256;
  }
  const bool sample = seq >= 16;
  const int d = tid & 31, qd = d >> 3;
  const float sg = (qd & 1) ? 1.f : -1.f;
  for (int i0 = 0; i0 < PT; i0 += 8) {
    if (!past) {
      float q[8], k[8], qp[8], kp[8];
#pragma unroll
      for (int t = 0; t < 8; ++t) {
        const bf16* pr = p.proj + (long)(r0 + i0 + t) * NPROJ;
        q[t] = bf2f(pr[C_AQ + tid]); k[t] = bf2f(pr[C_AK + tid]);
        qp[t] = bf2f(pr[C_AQ + (tid ^ 8)]); kp[t] = bf2f(pr[C_AK + (tid ^ 8)]);
      }
#pragma unroll
      for (int t = 0; t < 8; ++t) {
        const int i = i0 + t;
        float qq = q[t], kk = k[t];
        if (!sample) {
          p.out[O_DK + ((long)(seq * 4 + l) * 256 + pos0 + i) * 256 + tid] = kk;
        } else {
          float c, sn; rope_cs(p, pos0 + i, d, c, sn);
          qq = qq * c + sg * qp[t] * sn;
          kk = kk * c + sg * kp[t] * sn;
        }
        p.qd[(long)(r0 + i) * 256 + tid] = f2bf(qq * (0.17677669529663687f * LOG2E));
        p.kd[(long)(krow0 + i) * 256 + tid] = f2bf(kk);
      }
    } else {
      float k[8];
#pragma unroll
      for (int t = 0; t < 8; ++t) k[t] = ck[(i0 + t) * 256 + tid];
#pragma unroll
      for (int t = 0; t < 8; ++t) p.kd[(long)(krow0 + i0 + t) * 256 + tid] = f2bf(k[t]);
    }
  }
  int row0s, Ls, krow0s, Lk; long vtbase;
  seq_info(seq, row0s, Ls, krow0s, Lk, vtbase);
  const int key0 = pos0;
  for (int o0 = 0; o0 < PT / 8; o0 += 4) {
    float vv[4][8];
#pragma unroll
    for (int o = 0; o < 4; ++o)
#pragma unroll
      for (int j = 0; j < 8; ++j) {
        if (!past) vv[o][j] = bf2f(p.proj[(long)(r0 + (o0 + o) * 8 + j) * NPROJ + C_AV + tid]);
        else vv[o][j] = cv[((o0 + o) * 8 + j) * 256 + tid];
      }
#pragma unroll
    for (int o = 0; o < 4; ++o) {
      if (!past && !sample) {
#pragma unroll
        for (int j = 0; j < 8; ++j) p.out[O_DV + ((long)(seq * 4 + l) * 256 + pos0 + (o0 + o) * 8 + j) * 256 + tid] = vv[o][j];
      }
      u32x4 pk; pk[0] = pack2(vv[o][0], vv[o][1]); pk[1] = pack2(vv[o][2], vv[o][3]); pk[2] = pack2(vv[o][4], vv[o][5]); pk[3] = pack2(vv[o][6], vv[o][7]);
      *(u32x4*)(p.vtd + vtbase + (long)tid * Lk + key0 + (o0 + o) * 8) = pk;
    }
  }
}

__device__ __forceinline__ void prep_mla(const P& p, int l, int tile) {
  const int tid_ = get_tid(); const int lane = tid_ & 63, w = tid_ >> 6;
  const bool past = tile >= NT_OWN;
  if (!past) {
    const f32x4 gq = *(const f32x4*)(p.in[19] + l * 256 + lane * 4);
    const float kv0 = p.in[20][l * 128 + lane * 2], kv1 = p.in[20][l * 128 + lane * 2 + 1];
    for (int ii0 = 0; ii0 < PT / 4; ii0 += 4) {
      u32x2 cq[4]; unsigned ck[4]; float krv[4];
#pragma unroll
      for (int t = 0; t < 4; ++t) {
        const bf16* pr = p.proj + (long)(tile * PT + (ii0 + t) * 4 + w) * NPROJ;
        cq[t] = *(const u32x2*)(pr + C_CQ + lane * 4);
        ck[t] = *(const unsigned*)(pr + C_CKV + lane * 2);
        krv[t] = bf2f(pr[C_CKR + (lane & 31)]);
      }
#pragma unroll
      for (int t = 0; t < 4; ++t) {
        int r = tile * PT + (ii0 + t) * 4 + w, seq, pos, L, krow, modi;
        tok_info(r, seq, pos, L, krow, modi);
        float a0 = lo2f(cq[t][0]), a1 = hi2f(cq[t][0]), a2 = lo2f(cq[t][1]), a3 = hi2f(cq[t][1]);
        float ss = wave_sum(a0 * a0 + a1 * a1 + a2 * a2 + a3 * a3);
        float rs = rsqrtf(ss * (1.f / 256.f) + EPS_F);
        u32x2 oq; oq[0] = pack2(a0 * rs * gq[0], a1 * rs * gq[1]); oq[1] = pack2(a2 * rs * gq[2], a3 * rs * gq[3]);
        *(u32x2*)(p.cqn + (long)r * LDQ + lane * 4) = oq;
        float b0 = lo2f(ck[t]), b1 = hi2f(ck[t]);
        float s2 = wave_sum(b0 * b0 + b1 * b1);
        float rs2 = rsqrtf(s2 * (1.f / 128.f) + EPS_F);
        b0 = b0 * rs2 * kv0; b1 = b1 * rs2 * kv1;
        *(unsigned*)(p.ckv + (long)krow * LDC + lane * 2) = pack2(b0, b1);
        float kr = krv[t];
        float kp = __shfl_xor(kr, 8);
        if (seq < 16) {
          long o = ((long)(seq * 4 + l) * 256 + pos);
          p.out[O_CKV + o * 128 + lane * 2] = b0; p.out[O_CKV + o * 128 + lane * 2 + 1] = b1;
          if (lane < 32) p.out[O_KR + o * 32 + lane] = kr;
        } else {
          float c, sn; rope_cs(p, pos, lane & 31, c, sn);
          float sg = ((lane >> 3) & 1) ? 1.f : -1.f;
          kr = kr * c + sg * kp * sn;
        }
        if (lane < 32) p.kr[(long)krow * 32 + lane] = f2bf(kr);
      }
    }
  } else {
    const int b = (tile - NT_OWN) / (256 / PT), j0 = ((tile - NT_OWN) % (256 / PT)) * PT;
    for (int ii0 = 0; ii0 < PT / 4; ii0 += 4) {
      float c1a[4], c1b[4], c2v[4];
#pragma unroll
      for (int t = 0; t < 4; ++t) {
        const int j = j0 + (ii0 + t) * 4 + w;
        const float* c1 = p.in[5] + ((long)(b * 4 + l) * 256 + j) * 128;
        const float* c2 = p.in[6] + ((long)(b * 4 + l) * 256 + j) * 32;
        c1a[t] = c1[lane * 2]; c1b[t] = c1[lane * 2 + 1]; c2v[t] = c2[lane & 31];
      }
#pragma unroll
      for (int t = 0; t < 4; ++t) {
        const int j = j0 + (ii0 + t) * 4 + w;
        const int krow = NPROMPT + b * 4352 + 4096 + j;
        *(unsigned*)(p.ckv + (long)krow * LDC + lane * 2) = pack2(c1a[t], c1b[t]);
        if (lane < 32) p.kr[(long)krow * 32 + lane] = f2bf(c2v[t]);
      }
    }
  }
}

__device__ __forceinline__ void prep_dn(const P& p, int l, int tile) {
  const int tid = get_tid();
  const int r0 = tile * PT;
  int seq, pos0, L, krow, modi;
  tok_info(r0, seq, pos0, L, krow, modi);
  const float* cw = p.in[15] + (long)l * 3 * 768;
  float w0[3], w1[3], w2[3];
#pragma unroll
  for (int c = 0; c < 3; ++c) { w0[c] = cw[c * 256 + tid]; w1[c] = cw[768 + c * 256 + tid]; w2[c] = cw[1536 + c * 256 + tid]; }
  const float alog = __expf(p.in[16][l * 8 + (tid & 7)]), dtb = p.in[17][l * 8 + (tid & 7)];
  const bf16* pj = p.proj + C_BQKV + tid;
  for (int i0 = 0; i0 < PT; i0 += 16) {
    float v[3][18];
#pragma unroll
    for (int t = 0; t < 18; ++t) {
      const int pos = pos0 + i0 + t - 1;
      const bool ok = (pos >= 0) && (pos < L) && (i0 + t - 1 >= 0 || pos0 > 0);
      const int rr = ok ? (r0 + i0 + t - 1) : r0;
#pragma unroll
      for (int c = 0; c < 3; ++c) { float x = bf2f(pj[(long)rr * NPROJ + c * 256]); v[c][t] = ok ? x : 0.f; }
    }
    float braw[16], draw[16];
#pragma unroll
    for (int t = 0; t < 16; ++t) {
      const bf16* pr = p.proj + (long)(r0 + i0 + t) * NPROJ;
      braw[t] = bf2f(pr[C_BBETA + (tid & 7)]); draw[t] = bf2f(pr[C_BDECAY + (tid & 7)]);
    }
#pragma unroll
    for (int t = 0; t < 16; ++t) {
      float y[3];
#pragma unroll
      for (int c = 0; c < 3; ++c) y[c] = siluf(w0[c] * v[c][t] + w1[c] * v[c][t + 1] + w2[c] * v[c][t + 2]);
      float sq = wave_sum(y[0] * y[0]);
      float sk = wave_sum(y[1] * y[1]);
      long o = (long)(r0 + i0 + t) * 256 + tid;
      p.dq[o] = f2bf(y[0] * rsqrtf(sq + EPS_F) * 0.125f); p.dk[o] = f2bf(y[1] * rsqrtf(sk + EPS_F)); p.dv[o] = f2bf(y[2]);
      if (tid < 8) {
        p.dbeta[(long)(r0 + i0 + t) * 8 + tid] = sigmoidf_(braw[t]);
        p.dg[(long)(r0 + i0 + t) * 8 + tid] = -alog * softplusf_(draw[t] + dtb);
      }
    }
  }
}

__device__ __forceinline__ void prep_ssd(const P& p, int l, int tile) {
  const int tid = get_tid();
  const int r0 = tile * PT;
  int seq, pos0, L, krow, modi;
  tok_info(r0, seq, pos0, L, krow, modi);
  const float* cw = p.in[24] + (long)l * 3 * 768;
  const float* cb = p.in[25] + (long)l * 768;
  float w0[3], w1[3], w2[3], bs[3];
#pragma unroll
  for (int c = 0; c < 3; ++c) { w0[c] = cw[c * 256 + tid]; w1[c] = cw[768 + c * 256 + tid]; w2[c] = cw[1536 + c * 256 + tid]; bs[c] = cb[c * 256 + tid]; }
  const float dtb = p.in[27][l * 8 + (tid & 7)];
  const bf16* pj = p.proj + C_DXBC + tid;
  for (int i0 = 0; i0 < PT; i0 += 16) {
    float v[3][18];
#pragma unroll
    for (int t = 0; t < 18; ++t) {
      const int pos = pos0 + i0 + t - 1;
      const bool ok = (pos >= 0) && (pos < L) && (i0 + t - 1 >= 0 || pos0 > 0);
      const int rr = ok ? (r0 + i0 + t - 1) : r0;
#pragma unroll
      for (int c = 0; c < 3; ++c) { float x = bf2f(pj[(long)rr * NPROJ + c * 256]); v[c][t] = ok ? x : 0.f; }
    }
    float draw[16];
#pragma unroll
    for (int t = 0; t < 16; ++t) draw[t] = bf2f(p.proj[(long)(r0 + i0 + t) * NPROJ + C_DDT + (tid & 7)]);
#pragma unroll
    for (int t = 0; t < 16; ++t) {
      long o = (long)(r0 + i0 + t) * 256 + tid;
      p.sx[o] = f2bf(siluf(w0[0] * v[0][t] + w1[0] * v[0][t + 1] + w2[0] * v[0][t + 2] + bs[0]));
      p.sb[o] = f2bf(siluf(w0[1] * v[1][t] + w1[1] * v[1][t + 1] + w2[1] * v[1][t + 2] + bs[1]));
      p.sc[o] = f2bf(siluf(w0[2] * v[2][t] + w1[2] * v[2][t + 1] + w2[2] * v[2][t + 2] + bs[2]));
      if (tid < 8) p.sdt[(long)(r0 + i0 + t) * 8 + tid] = softplusf_(draw[t] + dtb);
    }
  }
}

__device__ __forceinline__ void dn_chunk_prep(const P& p, int item, char* smem) {
  const int tid = get_tid(), lane = tid & 63, w = tid >> 6, g = lane >> 4, lr = lane & 15;
  const int dir = item & 1, h = (item >> 1) & 3, cgi = item >> 3;
  const int r0 = cgi * 64;
  char* sQ = smem; char* sK = smem + 9216; char* sV = smem + 18432;
  float* sA = (float*)(smem + 27648);
  bf16* sQKM = (bf16*)(smem + 44032);
  bf16* sW = (bf16*)(smem + 52224);
  float* sGc = (float*)(smem + 60416);
  float* sBeta = (float*)(smem + 60672);
  for (int id = tid; id < 512; id += NTHR) {
    int i = id >> 3, ch = id & 7;
    int r = r0 + (dir ? 63 - i : i);
    long go = (long)r * 256 + h * 64 + ch * 8;
    *(u32x4*)(sQ + i * 144 + ch * 16) = *(const u32x4*)(p.dq + go);
    *(u32x4*)(sK + i * 144 + ch * 16) = *(const u32x4*)(p.dk + go);
    *(u32x4*)(sV + i * 144 + ch * 16) = *(const u32x4*)(p.dv + go);
  }
  if (w == 0) {
    int r = r0 + (dir ? 63 - lane : lane);
    float gv = p.dg[(long)r * 8 + dir * 4 + h];
    sBeta[lane] = p.dbeta[(long)r * 8 + dir * 4 + h];
#pragma unroll
    for (int o = 1; o < 64; o <<= 1) { float t = __shfl_up(gv, o); if (lane >= o) gv += t; }
    sGc[lane] = gv;
  }
  __syncthreads();
  const float gl = sGc[63];
  if (tid == 0) p.pgl[item] = gl;
  {
    bf16x8 aK[2], aQ[2];
#pragma unroll
    for (int ks = 0; ks < 2; ++ks) {
      aK[ks] = *(const bf16x8*)(sK + (16 * w + lr) * 144 + ks * 64 + g * 16);
      aQ[ks] = *(const bf16x8*)(sQ + (16 * w + lr) * 144 + ks * 64 + g * 16);
    }
#pragma unroll
    for (int nt = 0; nt < 4; ++nt) {
      f32x4 kk = (f32x4){0.f, 0.f, 0.f, 0.f}, qk = (f32x4){0.f, 0.f, 0.f, 0.f};
#pragma unroll
      for (int ks = 0; ks < 2; ++ks) {
        bf16x8 bK = *(const bf16x8*)(sK + (16 * nt + lr) * 144 + ks * 64 + g * 16);
        kk = mfma(aK[ks], bK, kk);
        qk = mfma(aQ[ks], bK, qk);
      }
      const int jj = 16 * nt + lr;
      const float gj = sGc[jj];
#pragma unroll
      for (int j = 0; j < 4; ++j) {
        const int i = 16 * w + 4 * g + j;
        float dec = (i >= jj) ? __expf(sGc[i] - gj) : 0.f;
        sA[i * 64 + jj] = (i > jj) ? sBeta[i] * kk[j] * dec : 0.f;
        sQKM[i * 64 + permk(jj)] = f2bf(qk[j] * dec);
      }
    }
  }
  const long ob = (long)item * 4096;
  __syncthreads();
  if (tid < 128) {
    const int c = tid & 63;
    const bool isw = tid >= 64;
    const char* src = isw ? sK : sV;
    float acol[64], x[64];
#pragma unroll
    for (int i = 0; i < 64; ++i) acol[i] = sA[i * 64 + lane];
#pragma unroll
    for (int i = 0; i < 64; ++i) {
      float r = bf2f(*(const bf16*)(src + i * 144 + c * 2)) * sBeta[i];
      x[i] = isw ? r * __expf(sGc[i]) : r;
    }
#pragma unroll
    for (int i = 1; i < 64; ++i) {
      float acc0 = x[i], acc1 = 0.f;
#pragma unroll
      for (int j = 0; j < i; ++j) {
        const float a = __builtin_bit_cast(float, __builtin_amdgcn_readlane(__builtin_bit_cast(int, acol[i]), j));
        if (j & 1) acc1 -= a * x[j]; else acc0 -= a * x[j];
      }
      x[i] = acc0 + acc1;
    }
    if (!isw) {
#pragma unroll
      for (int q = 0; q < 8; ++q) {
        u32x4 o;
        o[0] = pack2(x[q * 8 + 0], x[q * 8 + 1]); o[1] = pack2(x[q * 8 + 2], x[q * 8 + 3]);
        o[2] = pack2(x[q * 8 + 4], x[q * 8 + 5]); o[3] = pack2(x[q * 8 + 6], x[q * 8 + 7]);
        *(u32x4*)(p.pu + ob + c * 64 + q * 8) = o;
      }
    } else {
      const int pc = permk(c);
#pragma unroll
      for (int i = 0; i < 64; ++i) sW[i * 64 + pc] = f2bf(x[i]);
    }
    } else {
    const int t2 = tid - 128;
    for (int id = t2; id < 512; id += 128) {
      int i = id >> 3, c8 = id & 7;
      int blk = (c8 >> 2) * 32, gg = c8 & 3;
      float e = __expf(sGc[i]);
      u32x2 lo = *(const u32x2*)(sQ + i * 144 + (blk + 4 * gg) * 2);
      u32x2 hi = *(const u32x2*)(sQ + i * 144 + (blk + 16 + 4 * gg) * 2);
      u32x4 o;
      o[0] = pack2(lo2f(lo[0]) * e, hi2f(lo[0]) * e); o[1] = pack2(lo2f(lo[1]) * e, hi2f(lo[1]) * e);
      o[2] = pack2(lo2f(hi[0]) * e, hi2f(hi[0]) * e); o[3] = pack2(lo2f(hi[1]) * e, hi2f(hi[1]) * e);
      *(u32x4*)(p.pqd + ob + i * 64 + c8 * 8) = o;
    }
    for (int id = t2; id < 512; id += 128) {
      int d = id >> 3, c8 = id & 7;
      int blk = (c8 >> 2) * 32, gg = c8 & 3;
      float vals[8];
#pragma unroll
      for (int e = 0; e < 8; ++e) {
        int i = blk + ((e < 4) ? (4 * gg + e) : (16 + 4 * gg + e - 4));
        vals[e] = bf2f(*(const bf16*)(sK + i * 144 + d * 2)) * __expf(gl - sGc[i]);
      }
      u32x4 o; o[0] = pack2(vals[0], vals[1]); o[1] = pack2(vals[2], vals[3]); o[2] = pack2(vals[4], vals[5]); o[3] = pack2(vals[6], vals[7]);
      *(u32x4*)(p.pkd + ob + d * 64 + c8 * 8) = o;
    }
    for (int id = t2; id < 512; id += 128) *(u32x4*)(p.pqk + ob + id * 8) = *(const u32x4*)(sQKM + id * 8);
  }
  __syncthreads();
  for (int id = tid; id < 512; id += NTHR) *(u32x4*)(p.pw + ob + id * 8) = *(const u32x4*)(sW + id * 8);
  __syncthreads();
}

__device__ __forceinline__ void ssd_chunk_prep(const P& p, int l, int item, char* smem) {
  const int tid = get_tid(), lane = tid & 63, w = tid >> 6, g = lane >> 4, lr = lane & 15;
  const int dir = item & 1, h = (item >> 1) & 3, cgi = item >> 3, gr = h >> 1;
  const int r0 = cgi * 64;
  char* sB = smem; char* sC = smem + 17408; char* sXT = smem + 34816; char* sBT = smem + 44032;
  float* sAc = (float*)(smem + 62464);
  float* sDt = (float*)(smem + 62720);
  if (w == 0) {
    int r = r0 + (dir ? 63 - lane : lane);
    float dt = p.sdt[(long)r * 8 + dir * 4 + h];
    float a = -__expf(p.in[26][l * 8 + dir * 4 + h]);
    float v = dt * a;
#pragma unroll
    for (int o = 1; o < 64; o <<= 1) { float t = __shfl_up(v, o); if (lane >= o) v += t; }
    sAc[lane] = v; sDt[lane] = dt;
  }
  for (int id = tid; id < 1024; id += NTHR) {
    int i = id >> 4, ch = id & 15;
    int r = r0 + (dir ? 63 - i : i);
    long go = (long)r * 256 + gr * 128 + ch * 8;
    *(u32x4*)(sB + i * 272 + ch * 16) = *(const u32x4*)(p.sb + go);
    *(u32x4*)(sC + i * 272 + ch * 16) = *(const u32x4*)(p.sc + go);
  }
  __syncthreads();
  const float last = sAc[63];
  if (tid == 0) p.plast[item] = last;
  for (int id = tid; id < 512; id += NTHR) {
    int i = id >> 3, ch = id & 7;
    int r = r0 + (dir ? 63 - i : i);
    u32x4 v = *(const u32x4*)(p.sx + (long)r * 256 + h * 64 + ch * 8);
    float dt = sDt[i];
#pragma unroll
    for (int q = 0; q < 4; ++q) {
      *(bf16*)(sXT + (ch * 8 + 2 * q) * 144 + i * 2) = f2bf(lo2f(v[q]) * dt);
      *(bf16*)(sXT + (ch * 8 + 2 * q + 1) * 144 + i * 2) = f2bf(hi2f(v[q]) * dt);
    }
  }
  for (int id = tid; id < 1024; id += NTHR) {
    int i = id >> 4, ch = id & 15;
    u32x4 v = *(const u32x4*)(sB + i * 272 + ch * 16);
    float e = __expf(last - sAc[i]);
#pragma unroll
    for (int q = 0; q < 4; ++q) {
      *(bf16*)(sBT + (ch * 8 + 2 * q) * 144 + i * 2) = f2bf(lo2f(v[q]) * e);
      *(bf16*)(sBT + (ch * 8 + 2 * q + 1) * 144 + i * 2) = f2bf(hi2f(v[q]) * e);
    }
  }
  const long ob = (long)item * 8192;
  for (int id = tid; id < 1024; id += NTHR) {
    int i = id >> 4, c8 = id & 15;
    int blk = (c8 >> 2) * 32, gg = c8 & 3;
    float e = __expf(sAc[i]);
    u32x2 lo = *(const u32x2*)(sC + i * 272 + (blk + 4 * gg) * 2);
    u32x2 hi = *(const u32x2*)(sC + i * 272 + (blk + 16 + 4 * gg) * 2);
    u32x4 o;
    o[0] = pack2(lo2f(lo[0]) * e, hi2f(lo[0]) * e); o[1] = pack2(lo2f(lo[1]) * e, hi2f(lo[1]) * e);
    o[2] = pack2(lo2f(hi[0]) * e, hi2f(hi[0]) * e); o[3] = pack2(lo2f(hi[1]) * e, hi2f(hi[1]) * e);
    *(u32x4*)(p.pcd + ob + i * 128 + c8 * 8) = o;
  }
  __syncthreads();
  f32x4 G[4];
#pragma unroll
  for (int mt = 0; mt < 4; ++mt) G[mt] = (f32x4){0.f, 0.f, 0.f, 0.f};
#pragma unroll
  for (int ks = 0; ks < 4; ++ks) {
    bf16x8 bC = *(const bf16x8*)(sC + (16 * w + lr) * 272 + ks * 64 + g * 16);
#pragma unroll
    for (int mt = 0; mt < 4; ++mt) {
      bf16x8 aB = *(const bf16x8*)(sB + (16 * mt + lr) * 272 + ks * 64 + g * 16);
      G[mt] = mfma(aB, bC, G[mt]);
    }
  }
  {
    const int i = 16 * w + lr;
    const float ai = sAc[i];
#pragma unroll
    for (int mt = 0; mt < 4; ++mt)
#pragma unroll
      for (int j = 0; j < 4; ++j) {
        int jj = 16 * mt + 4 * g + j;
        G[mt][j] = (i >= jj) ? G[mt][j] * __expf(ai - sAc[jj]) : 0.f;
      }
  }
  bf16x8 bM[2];
  bM[0] = pack8(G[0], G[1]); bM[1] = pack8(G[2], G[3]);
  {
    float* Y = dir ? p.yb : p.yf;
    const int i = 16 * w + lr;
    const int r = r0 + (dir ? 63 - i : i);
#pragma unroll
    for (int mp = 0; mp < 4; ++mp) {
      f32x4 y = (f32x4){0.f, 0.f, 0.f, 0.f};
#pragma unroll
      for (int kb = 0; kb < 2; ++kb) {
        u32x2 lo = *(const u32x2*)(sXT + (16 * mp + lr) * 144 + (kb * 32 + 4 * g) * 2);
        u32x2 hi = *(const u32x2*)(sXT + (16 * mp + lr) * 144 + (kb * 32 + 16 + 4 * g) * 2);
        u32x4 a; a[0] = lo[0]; a[1] = lo[1]; a[2] = hi[0]; a[3] = hi[1];
        y = mfma(__builtin_bit_cast(bf16x8, a), bM[kb], y);
      }
      *(f32x4*)(Y + (long)r * 256 + h * 64 + 16 * mp + 4 * g) = y;
    }
  }
  {
    bf16x8 bX[2];
#pragma unroll
    for (int ks = 0; ks < 2; ++ks) bX[ks] = *(const bf16x8*)(sXT + (16 * w + lr) * 144 + ks * 64 + g * 16);
#pragma unroll
    for (int mt = 0; mt < 8; ++mt) {
      f32x4 s = (f32x4){0.f, 0.f, 0.f, 0.f};
#pragma unroll
      for (int ks = 0; ks < 2; ++ks) {
        bf16x8 a = *(const bf16x8*)(sBT + (16 * mt + lr) * 144 + ks * 64 + g * 16);
        s = mfma(a, bX[ks], s);
      }
      u32x2 o; o[0] = pack2(s[0], s[1]); o[1] = pack2(s[2], s[3]);
      *(u32x2*)(p.pst + ob + (16 * w + lr) * 128 + 16 * mt + 4 * g) = o;
    }
  }
  __syncthreads();
}

__device__ __forceinline__ void dn_chain(const P& p, int l, int cidx, char* smem) {
  const int tid = get_tid(), lane = tid & 63, w = tid >> 6, g = lane >> 4, lr = lane & 15;
  const int dir = cidx & 1, h = (cidx >> 1) & 3, seq = cidx >> 3;
  int row0, L, krow0, Lk; long vtb;
  seq_info(seq, row0, L, krow0, Lk, vtb);
  const int n = L >> 6, cg0 = row0 >> 6;
  const int dvc = 16 * w + lr;
  constexpr int MSZ = 64 * 144, STG = 4 * MSZ;
  f32x4 S[4];
  if (seq >= 16) {
    const float* s0 = p.in[4] + ((((long)(seq - 16) * 4 + l) * 2 + dir) * 4 + h) * 4096;
#pragma unroll
    for (int mt = 0; mt < 4; ++mt)
#pragma unroll
      for (int j = 0; j < 4; ++j) S[mt][j] = s0[(16 * mt + 4 * g + j) * 64 + dvc];
  } else {
#pragma unroll
    for (int mt = 0; mt < 4; ++mt) S[mt] = (f32x4){0.f, 0.f, 0.f, 0.f};
  }
  bf16* O = dir ? p.ob : p.of;
  u32x4 rg[8]; u32x2 un[4]; float gln;
  auto item_of = [&](int c) __attribute__((always_inline)) { const int oc = dir ? n - 1 - c : c; return ((cg0 + oc) * 4 + h) * 2 + dir; };
  auto gload = [&](int item) __attribute__((always_inline)) {
    const long ob = (long)item * 4096;
#pragma unroll
    for (int i = 0; i < 8; ++i) {
      const int mat = i >> 1, rem = tid + 256 * (i & 1);
      const bf16* base = (mat == 0) ? p.pw : (mat == 1) ? p.pqd : (mat == 2) ? p.pqk : p.pkd;
      rg[i] = *(const u32x4*)(base + ob + rem * 8);
    }
#pragma unroll
    for (int mt = 0; mt < 4; ++mt) un[mt] = *(const u32x2*)(p.pu + ob + dvc * 64 + 16 * mt + 4 * g);
    gln = p.pgl[item];
  };
  auto sstore = [&](int st) __attribute__((always_inline)) {
#pragma unroll
    for (int i = 0; i < 8; ++i) {
      const int mat = i >> 1, rem = tid + 256 * (i & 1), row = rem >> 3, ch = rem & 7;
      *(u32x4*)(smem + st * STG + mat * MSZ + row * 144 + ch * 16) = rg[i];
    }
  };
  gload(item_of(0));
  sstore(0);
  __syncthreads();
  for (int c = 0; c < n; ++c) {
    const int oc = dir ? n - 1 - c : c;
    u32x2 uc[4];
#pragma unroll
    for (int mt = 0; mt < 4; ++mt) uc[mt] = un[mt];
    const float egl = __expf(gln);
    if (c + 1 < n) gload(item_of(c + 1));
    __builtin_amdgcn_sched_barrier(0);
    const char* sb = smem + (c & 1) * STG + lr * 144 + g * 16;
    bf16x8 bS[2];
    bS[0] = pack8(S[0], S[1]); bS[1] = pack8(S[2], S[3]);
    f32x4 vn[4], o[4];
#pragma unroll
    for (int mt = 0; mt < 4; ++mt) {
      f32x4 a = (f32x4){0.f, 0.f, 0.f, 0.f}, b = (f32x4){0.f, 0.f, 0.f, 0.f};
#pragma unroll
      for (int ks = 0; ks < 2; ++ks) {
        bf16x8 aw = *(const bf16x8*)(sb + 0 * MSZ + mt * 16 * 144 + ks * 64);
        bf16x8 aq = *(const bf16x8*)(sb + 1 * MSZ + mt * 16 * 144 + ks * 64);
        a = mfma(aw, bS[ks], a);
        b = mfma(aq, bS[ks], b);
      }
      vn[mt][0] = lo2f(uc[mt][0]) - a[0]; vn[mt][1] = hi2f(uc[mt][0]) - a[1];
      vn[mt][2] = lo2f(uc[mt][1]) - a[2]; vn[mt][3] = hi2f(uc[mt][1]) - a[3];
      o[mt] = b;
    }
    bf16x8 bV[2];
    bV[0] = pack8(vn[0], vn[1]); bV[1] = pack8(vn[2], vn[3]);
#pragma unroll
    for (int mt = 0; mt < 4; ++mt) {
      f32x4 sn;
#pragma unroll
      for (int j = 0; j < 4; ++j) sn[j] = S[mt][j] * egl;
#pragma unroll
      for (int kb = 0; kb < 2; ++kb) {
        bf16x8 aqk = *(const bf16x8*)(sb + 2 * MSZ + mt * 16 * 144 + kb * 64);
        bf16x8 akd = *(const bf16x8*)(sb + 3 * MSZ + mt * 16 * 144 + kb * 64);
        o[mt] = mfma(aqk, bV[kb], o[mt]);
        sn = mfma(akd, bV[kb], sn);
      }
      S[mt] = sn;
    }
#pragma unroll
    for (int mt = 0; mt < 4; ++mt)
#pragma unroll
      for (int j = 0; j < 4; ++j) {
        int i = 16 * mt + 4 * g + j;
        int r = (cg0 + oc) * 64 + (dir ? 63 - i : i);
        O[(long)r * 256 + h * 64 + dvc] = f2bf(o[mt][j]);
      }
    __builtin_amdgcn_sched_barrier(0);
    if (c + 1 < n) sstore((c + 1) & 1);
    __syncthreads();
  }
  if (seq < 16) {
    float* so = p.out + O_SD + ((((long)seq * 4 + l) * 2 + dir) * 4 + h) * 4096;
#pragma unroll
    for (int mt = 0; mt < 4; ++mt)
#pragma unroll
      for (int j = 0; j < 4; ++j) so[(16 * mt + 4 * g + j) * 64 + dvc] = S[mt][j];
  }
}

__device__ __forceinline__ void ssd_chain(const P& p, int l, int cidx, char* smem) {
  const int tid = get_tid(), lane = tid & 63, w = tid >> 6, g = lane >> 4, lr = lane & 15;
  const int dir = cidx & 1, h = (cidx >> 1) & 3, seq = cidx >> 3;
  int row0, L, krow0, Lk; long vtb;
  seq_info(seq, row0, L, krow0, Lk, vtb);
  const int n = L >> 6, cg0 = row0 >> 6;
  const int pc = 16 * w + lr;
  constexpr int STG = 64 * 272;
  f32x4 S[8];
  if (seq >= 16) {
    const float* s0 = p.in[7] + ((((long)(seq - 16) * 4 + l) * 2 + dir) * 4 + h) * 8192;
#pragma unroll
    for (int mt = 0; mt < 8; ++mt) S[mt] = *(const f32x4*)(s0 + pc * 128 + 16 * mt + 4 * g);
  } else {
#pragma unroll
    for (int mt = 0; mt < 8; ++mt) S[mt] = (f32x4){0.f, 0.f, 0.f, 0.f};
  }
  float* Y = dir ? p.yb : p.yf;
  u32x4 rg[4]; u32x2 stn[8]; float yn[16]; float lastn;
  auto item_of = [&](int c) __attribute__((always_inline)) { const int oc = dir ? n - 1 - c : c; return ((cg0 + oc) * 4 + h) * 2 + dir; };
  auto gload = [&](int c) __attribute__((always_inline)) {
    const int oc = dir ? n - 1 - c : c;
    const int item = ((cg0 + oc) * 4 + h) * 2 + dir;
    const long ob = (long)item * 8192;
#pragma unroll
    for (int i = 0; i < 4; ++i) rg[i] = *(const u32x4*)(p.pcd + ob + (tid + 256 * i) * 8);
#pragma unroll
    for (int mt = 0; mt < 8; ++mt) stn[mt] = *(const u32x2*)(p.pst + ob + pc * 128 + 16 * mt + 4 * g);
#pragma unroll
    for (int mt = 0; mt < 4; ++mt)
#pragma unroll
      for (int j = 0; j < 4; ++j) {
        int i = 16 * mt + 4 * g + j;
        int r = (cg0 + oc) * 64 + (dir ? 63 - i : i);
        yn[mt * 4 + j] = Y[(long)r * 256 + h * 64 + pc];
      }
    lastn = p.plast[item];
  };
  auto sstore = [&](int st) __attribute__((always_inline)) {
#pragma unroll
    for (int i = 0; i < 4; ++i) {
      const int id = tid + 256 * i, row = id >> 4, ch = id & 15;
      *(u32x4*)(smem + st * STG + row * 272 + ch * 16) = rg[i];
    }
  };
  gload(0);
  sstore(0);
  __syncthreads();
  for (int c = 0; c < n; ++c) {
    const int oc = dir ? n - 1 - c : c;
    u32x2 stc[8]; float yc[16];
#pragma unroll
    for (int mt = 0; mt < 8; ++mt) stc[mt] = stn[mt];
#pragma unroll
    for (int q = 0; q < 16; ++q) yc[q] = yn[q];
    const float el = __expf(lastn);
    if (c + 1 < n) gload(c + 1);
    __builtin_amdgcn_sched_barrier(0);
    const char* sb = smem + (c & 1) * STG + lr * 272 + g * 16;
    bf16x8 bS[4];
#pragma unroll
    for (int ks = 0; ks < 4; ++ks) bS[ks] = pack8(S[2 * ks], S[2 * ks + 1]);
#pragma unroll
    for (int mt = 0; mt < 4; ++mt) {
      f32x4 y = (f32x4){0.f, 0.f, 0.f, 0.f};
#pragma unroll
      for (int ks = 0; ks < 4; ++ks) {
        bf16x8 a = *(const bf16x8*)(sb + mt * 16 * 272 + ks * 64);
        y = mfma(a, bS[ks], y);
      }
#pragma unroll
      for (int j = 0; j < 4; ++j) {
        int i = 16 * mt + 4 * g + j;
        int r = (cg0 + oc) * 64 + (dir ? 63 - i : i);
        Y[(long)r * 256 + h * 64 + pc] = yc[mt * 4 + j] + y[j];
      }
    }
#pragma unroll
    for (int mt = 0; mt < 8; ++mt) {
      S[mt][0] = S[mt][0] * el + lo2f(stc[mt][0]); S[mt][1] = S[mt][1] * el + hi2f(stc[mt][0]);
      S[mt][2] = S[mt][2] * el + lo2f(stc[mt][1]); S[mt][3] = S[mt][3] * el + hi2f(stc[mt][1]);
    }
    __builtin_amdgcn_sched_barrier(0);
    if (c + 1 < n) sstore((c + 1) & 1);
    __syncthreads();
  }
  if (seq < 16) {
    float* so = p.out + O_SS + ((((long)seq * 4 + l) * 2 + dir) * 4 + h) * 8192;
#pragma unroll
    for (int mt = 0; mt < 8; ++mt) *(f32x4*)(so + pc * 128 + 16 * mt + 4 * g) = S[mt];
  }
}

template <bool MLA>
__device__ __forceinline__ void attn_item(const P& p, int l, int seq, int h, int qb, int sub, char* smem) {
  constexpr int KS = MLA ? 3 : 1;
  constexpr int KSTR = MLA ? 208 : 80;
  constexpr int NKC = MLA ? 3 : 1;
  constexpr int KCH = MLA ? 12 : 4;
  constexpr int BUF = 64 * KSTR + 64 * 144;
  const int tid = get_tid(), lane = tid & 63, w = tid >> 6, g = lane >> 4, lr = lane & 15;
  int row0, L, krow0, Lk; long vtbase;
  seq_info(seq, row0, L, krow0, Lk, vtbase);
  const int r0 = row0 + qb * 128 + w * 32;
  const int nkt = Lk >> 6;
  const bf16* vt = (MLA ? p.vtm : p.vtd) + vtbase + (long)h * 64 * Lk;
  bf16x8 bq[KS][2];
#pragma unroll
  for (int nt = 0; nt < 2; ++nt) {
    const int r = r0 + nt * 16 + lr;
    if (MLA) {
      const float sc = 0.10206207261596577f * LOG2E;
#pragma unroll
      for (int ks = 0; ks < KS; ++ks) {
        u32x4 v = *(const u32x4*)(p.qm + (long)r * 384 + h * 96 + ks * 32 + g * 8);
        u32x4 o;
#pragma unroll
        for (int q = 0; q < 4; ++q) o[q] = pack2(lo2f(v[q]) * sc, hi2f(v[q]) * sc);
        bq[ks][nt] = __builtin_bit_cast(bf16x8, o);
      }
    } else {
      bq[0][nt] = *(const bf16x8*)(p.qd + (long)r * 256 + h * 64 + sub * 32 + g * 8);
    }
  }
  f32x4 O[4][2];
  float mx[2], ls[2];
#pragma unroll
  for (int nt = 0; nt < 2; ++nt) {
    mx[nt] = 0.f; ls[nt] = 0.f;
#pragma unroll
    for (int mv = 0; mv < 4; ++mv) O[mv][nt] = (f32x4){0.f, 0.f, 0.f, 0.f};
  }
  u32x4 kreg0[NKC], vreg0[2], kreg1[NKC], vreg1[2];
  auto load_tile = [&](int kt, u32x4 (&kreg)[NKC], u32x4 (&vreg)[2]) __attribute__((always_inline)) {
#pragma unroll
    for (int i = 0; i < NKC; ++i) {
      int id = tid + 256 * i, key = id / KCH, ch = id % KCH;
      long kr = krow0 + kt * 64 + key;
      if (MLA) {
        if (ch < 8) kreg[i] = *(const u32x4*)(p.knope + kr * 256 + h * 64 + ch * 8);
        else kreg[i] = *(const u32x4*)(p.kr + kr * 32 + (ch - 8) * 8);
      } else kreg[i] = *(const u32x4*)(p.kd + kr * 256 + h * 64 + sub * 32 + ch * 8);
    }
#pragma unroll
    for (int i = 0; i < 2; ++i) {
      int id = tid + 256 * i, v = id >> 3, ch = id & 7;
      vreg[i] = *(const u32x4*)(vt + (long)v * Lk + kt * 64 + ch * 8);
    }
  };
  auto store_tile = [&](int b, const u32x4 (&kreg)[NKC], const u32x4 (&vreg)[2]) __attribute__((always_inline)) {
    char* sK = smem + b * BUF; char* sV = sK + 64 * KSTR;
#pragma unroll
    for (int i = 0; i < NKC; ++i) {
      int id = tid + 256 * i, key = id / KCH, ch = id % KCH;
      *(u32x4*)(sK + key * KSTR + ch * 16) = kreg[i];
    }
#pragma unroll
    for (int i = 0; i < 2; ++i) {
      int id = tid + 256 * i, v = id >> 3, ch = id & 7;
      int blk = (ch >> 2) * 32, u0 = 2 * (ch & 3), u1 = u0 + 1;
      int p0 = (u0 < 4) ? 2 * u0 : 2 * (u0 - 4) + 1, p1 = (u1 < 4) ? 2 * u1 : 2 * (u1 - 4) + 1;
      u32x2 a, bb; a[0] = vreg[i][0]; a[1] = vreg[i][1]; bb[0] = vreg[i][2]; bb[1] = vreg[i][3];
      *(u32x2*)(sV + v * 144 + (blk + p0 * 4) * 2) = a;
      *(u32x2*)(sV + v * 144 + (blk + p1 * 4) * 2) = bb;
    }
  };
  auto compute = [&](int cur) __attribute__((always_inline)) {
    const char* sK = smem + cur * BUF; const char* sV = sK + 64 * KSTR;
    f32x4 s[4][2];
    __builtin_amdgcn_s_setprio(1);
#pragma unroll
    for (int mt = 0; mt < 4; ++mt) {
      s[mt][0] = (f32x4){-mx[0], -mx[0], -mx[0], -mx[0]}; s[mt][1] = (f32x4){-mx[1], -mx[1], -mx[1], -mx[1]};
#pragma unroll
      for (int ks = 0; ks < KS; ++ks) {
        bf16x8 aK = *(const bf16x8*)(sK + (mt * 16 + lr) * KSTR + ks * 64 + g * 16);
        s[mt][0] = mfma(aK, bq[ks][0], s[mt][0]);
        s[mt][1] = mfma(aK, bq[ks][1], s[mt][1]);
      }
    }
    __builtin_amdgcn_s_setprio(0);
    float tm[2];
#pragma unroll
    for (int nt = 0; nt < 2; ++nt) {
      float t0 = fmaxf(fmaxf(s[0][nt][0], s[0][nt][1]), fmaxf(s[0][nt][2], s[0][nt][3]));
#pragma unroll
      for (int mt = 1; mt < 4; ++mt) t0 = fmaxf(t0, fmaxf(fmaxf(s[mt][nt][0], s[mt][nt][1]), fmaxf(s[mt][nt][2], s[mt][nt][3])));
      t0 = fmaxf(t0, __shfl_xor(t0, 16));
      t0 = fmaxf(t0, __shfl_xor(t0, 32));
      tm[nt] = t0;
    }
    if (__any((tm[0] > 8.f) || (tm[1] > 8.f))) {
#pragma unroll
      for (int nt = 0; nt < 2; ++nt) {
        const float d = fmaxf(tm[nt], 0.f);
        const float al = ex2(-d);
        mx[nt] += d; ls[nt] *= al;
#pragma unroll
        for (int mv = 0; mv < 4; ++mv)
#pragma unroll
          for (int j = 0; j < 4; ++j) O[mv][nt][j] *= al;
#pragma unroll
        for (int mt = 0; mt < 4; ++mt)
#pragma unroll
          for (int j = 0; j < 4; ++j) s[mt][nt][j] -= d;
      }
    }
    bf16x8 bP[2][2];
#pragma unroll
    for (int nt = 0; nt < 2; ++nt) {
      float su = 0.f;
#pragma unroll
      for (int mt = 0; mt < 4; ++mt)
#pragma unroll
        for (int j = 0; j < 4; ++j) { float e = ex2(s[mt][nt][j]); s[mt][nt][j] = e; su += e; }
      ls[nt] += su;
      bP[0][nt] = pack8(s[0][nt], s[1][nt]);
      bP[1][nt] = pack8(s[2][nt], s[3][nt]);
    }
    __builtin_amdgcn_s_setprio(1);
#pragma unroll
    for (int mv = 0; mv < 4; ++mv)
#pragma unroll
      for (int kb = 0; kb < 2; ++kb) {
        bf16x8 aV = *(const bf16x8*)(sV + (mv * 16 + lr) * 144 + kb * 64 + g * 16);
        O[mv][0] = mfma(aV, bP[kb][0], O[mv][0]);
        O[mv][1] = mfma(aV, bP[kb][1], O[mv][1]);
      }
    __builtin_amdgcn_s_setprio(0);
  };
  load_tile(0, kreg0, vreg0);
  load_tile(1, kreg1, vreg1);
  store_tile(0, kreg0, vreg0);
  __syncthreads();
  for (int kt = 0; kt < nkt; kt += 2) {
    load_tile(min(kt + 2, nkt - 1), kreg0, vreg0);
    __builtin_amdgcn_sched_barrier(0);
    compute(0);
    __builtin_amdgcn_sched_barrier(0);
    store_tile(1, kreg1, vreg1);
    __syncthreads();
    load_tile(min(kt + 3, nkt - 1), kreg1, vreg1);
    __builtin_amdgcn_sched_barrier(0);
    compute(1);
    __builtin_amdgcn_sched_barrier(0);
    store_tile(0, kreg0, vreg0);
    __syncthreads();
  }
#pragma unroll
  for (int nt = 0; nt < 2; ++nt) {
    const int r = r0 + nt * 16 + lr;
    float sm = ls[nt];
    sm += __shfl_xor(sm, 16); sm += __shfl_xor(sm, 32);
    const float inv = 1.f / sm;
    if (MLA) {
#pragma unroll
      for (int mv = 0; mv < 4; ++mv) {
        u32x2 o; o[0] = pack2(O[mv][nt][0] * inv, O[mv][nt][1] * inv);
        o[1] = pack2(O[mv][nt][2] * inv, O[mv][nt][3] * inv);
        *(u32x2*)(p.hbf + (long)r * LDH + 512 + h * 64 + mv * 16 + 4 * g) = o;
      }
    } else {
#pragma unroll
      for (int mv = 0; mv < 4; ++mv) {
        u32x2 o; o[0] = pack2(O[mv][nt][0] * inv, O[mv][nt][1] * inv); o[1] = pack2(O[mv][nt][2] * inv, O[mv][nt][3] * inv);
        *(u32x2*)(p.ao + ((long)sub * NTOK + r) * 256 + h * 64 + mv * 16 + 4 * g) = o;
      }
    }
  }
}

#define P4_ITEMS 1440
__device__ __forceinline__ void p4_item(const P& p, int l, int it, char* smem, int skip_ssd) {
  int kind, a0 = 0, a1 = 0, a2 = 0, a3 = 0;
  if (it < 16) { kind = 0; a0 = 128 + it; }
  else if (it < 32) { kind = 1; a0 = 128 + it - 16; }
  else if (it < 288) { int q = it - 32; kind = 3; a0 = 16 + (q >> 7); a1 = (q >> 5) & 3; a2 = q & 31; }
  else if (it < 800) { int q = it - 288; kind = 2; a3 = q & 1; q >>= 1; a0 = 16 + (q >> 7); a1 = (q >> 5) & 3; a2 = q & 31; }
  else if (it < 928) { kind = 0; a0 = it - 800; }
  else if (it < 1056) { kind = 1; a0 = it - 928; }
  else if (it < 1184) { int q = it - 1056; kind = 3; a0 = q >> 3; a1 = (q >> 1) & 3; a2 = q & 1; }
  else { int q = it - 1184; kind = 2; a3 = q & 1; q >>= 1; a0 = q >> 3; a1 = (q >> 1) & 3; a2 = q & 1; }
  if (kind == 0) { __builtin_amdgcn_s_setprio(3); dn_chain(p, l, a0, smem); __builtin_amdgcn_s_setprio(0); }
  else if (kind == 1) { if (!skip_ssd) { __builtin_amdgcn_s_setprio(3); ssd_chain(p, l, a0, smem); __builtin_amdgcn_s_setprio(0); } }
  else if (kind == 2) attn_item<false>(p, l, a0, a1, a2, a3, smem);
  else attn_item<true>(p, l, a0, a1, a2, 0, smem);
}

__device__ __forceinline__ void finalize_rows(const P& p, int l, int item) {
  const int tid_ = get_tid(); const int lane = tid_ & 63, w = tid_ >> 6;
  const int r = item * 4 + w;
  const bf16* pr = p.proj + (long)r * NPROJ;
  const int c = lane * 4;
  {
    const float* lp = p.in[13] + l * 128;
    float d0 = 0.f, d1 = 0.f;
    for (int i = 0; i < 32; ++i) { d0 += lp[i] * lp[32 + i]; d1 += lp[64 + i] * lp[96 + i]; }
    const float lam_init = 0.8f - 0.6f * expf(-0.3f * (float)l);
    const float lam = expf(d0) - expf(d1) + lam_init;
    const u32x2 ua = *(const u32x2*)(p.ao + (long)r * 256 + c), ub = *(const u32x2*)(p.ao + ((long)NTOK + r) * 256 + c);
    const f32x4 a = (f32x4){lo2f(ua[0]), hi2f(ua[0]), lo2f(ua[1]), hi2f(ua[1])}, b = (f32x4){lo2f(ub[0]), hi2f(ub[0]), lo2f(ub[1]), hi2f(ub[1])};
    float o[4], ss = 0.f;
#pragma unroll
    for (int j = 0; j < 4; ++j) { o[j] = a[j] - lam * b[j]; ss += o[j] * o[j]; }
    ss += __shfl_xor(ss, 1); ss += __shfl_xor(ss, 2); ss += __shfl_xor(ss, 4); ss += __shfl_xor(ss, 8);
    float rs = rsqrtf(ss * (1.f / 64.f) + EPS_F) * (1.f - lam_init);
    f32x4 gn = *(const f32x4*)(p.in[14] + l * 64 + (c & 63));
    u32x2 out;
    out[0] = pack2(o[0] * rs * gn[0], o[1] * rs * gn[1]);
    out[1] = pack2(o[2] * rs * gn[2], o[3] * rs * gn[3]);
    *(u32x2*)(p.hbf + (long)r * LDH + c) = out;
  }
  {
    const u32x2 ua = *(const u32x2*)(p.of + (long)r * 256 + c), ub = *(const u32x2*)(p.ob + (long)r * 256 + c);
    const f32x4 a = (f32x4){lo2f(ua[0]), hi2f(ua[0]), lo2f(ua[1]), hi2f(ua[1])}, b = (f32x4){lo2f(ub[0]), hi2f(ub[0]), lo2f(ub[1]), hi2f(ub[1])};
    float o[4], ss = 0.f;
#pragma unroll
    for (int j = 0; j < 4; ++j) { o[j] = a[j] + b[j]; ss += o[j] * o[j]; }
    ss += __shfl_xor(ss, 1); ss += __shfl_xor(ss, 2); ss += __shfl_xor(ss, 4); ss += __shfl_xor(ss, 8);
    float rs = rsqrtf(ss * (1.f / 64.f) + EPS_F);
    f32x4 gn = *(const f32x4*)(p.in[18] + l * 64 + (c & 63));
    u32x2 gt = *(const u32x2*)(pr + C_BGATE + c);
    float gv[4] = {lo2f(gt[0]), hi2f(gt[0]), lo2f(gt[1]), hi2f(gt[1])};
    u32x2 out;
    out[0] = pack2(o[0] * rs * gn[0] * siluf(gv[0]), o[1] * rs * gn[1] * siluf(gv[1]));
    out[1] = pack2(o[2] * rs * gn[2] * siluf(gv[2]), o[3] * rs * gn[3] * siluf(gv[3]));
    *(u32x2*)(p.hbf + (long)r * LDH + 256 + c) = out;
  }
  {
    f32x4 a = *(const f32x4*)(p.yf + (long)r * 256 + c), b = *(const f32x4*)(p.yb + (long)r * 256 + c);
    u32x2 xx = *(const u32x2*)(p.sx + (long)r * 256 + c);
    u32x2 zz = *(const u32x2*)(pr + C_DZ + c);
    float xv[4] = {lo2f(xx[0]), hi2f(xx[0]), lo2f(xx[1]), hi2f(xx[1])};
    float zv[4] = {lo2f(zz[0]), hi2f(zz[0]), lo2f(zz[1]), hi2f(zz[1])};
    float dsk = p.in[28][l * 4 + (lane >> 4)];
    float y[4], ss = 0.f;
#pragma unroll
    for (int j = 0; j < 4; ++j) { y[j] = (a[j] + b[j] + dsk * xv[j]) * siluf(zv[j]); ss += y[j] * y[j]; }
    ss += __shfl_xor(ss, 1); ss += __shfl_xor(ss, 2); ss += __shfl_xor(ss, 4); ss += __shfl_xor(ss, 8); ss += __shfl_xor(ss, 16);
    float rs = rsqrtf(ss * (1.f / 128.f) + EPS_F);
    f32x4 gn = *(const f32x4*)(p.in[29] + l * 256 + c);
    u32x2 out;
    out[0] = pack2(y[0] * rs * gn[0], y[1] * rs * gn[1]);
    out[1] = pack2(y[2] * rs * gn[2], y[3] * rs * gn[3]);
    *(u32x2*)(p.hbf + (long)r * LDH + 768 + c) = out;
  }
}

struct EpiProj {
  static constexpr bool STAGED = true;
  bf16* dst; int ld;
  __device__ __forceinline__ f32x4 transform(int r, int c, f32x4 v) const { return v; }
};
struct EpiRes {
  static constexpr bool STAGED = true;
  bf16* dst; int ld;
  const bf16* xb; const float* mod; int gate_idx; int l;
  __device__ __forceinline__ f32x4 transform(int r, int c, f32x4 v) const {
    const int modi = (r < NPROMPT) ? 0 : 1 + ((r - NPROMPT) >> 12);
    const float gt = mod[((long)l * 3 + modi) * 6144 + gate_idx * 1024 + c];
#pragma unroll
    for (int j = 0; j < 4; ++j) v[j] = ALPHA_F * bf2f(xb[(long)(r + j) * 2048 + c]) + gt * v[j];
    return v;
  }
};
struct EpiAct {
  static constexpr bool STAGED = true;
  bf16* dst; int ld;
  __device__ __forceinline__ f32x4 transform(int r, int c, f32x4 v) const {
#pragma unroll
    for (int j = 0; j < 4; ++j) { float x = fmaxf(v[j], 0.f); v[j] = x * x; }
    return v;
  }
};
struct EpiUq {
  static constexpr bool STAGED = true;
  bf16* dst; int ld;
  const P* p;
  __device__ __forceinline__ f32x4 transform(int r, int c, f32x4 v) const {
    const int cc = c % 96;
    const bool ropecol = cc >= 64;
    const int d = (cc - 64) & 31;
    const float sg = ((d >> 3) & 1) ? 1.f : -1.f;
#pragma unroll
    for (int j = 0; j < 4; ++j) {
      float x = v[j];
      float xp = __shfl_xor(x, 8);
      const int rr = r + j;
      if (ropecol && rr >= NPROMPT) {
        float cs, sn; rope_cs(*p, (rr - NPROMPT) & 4095, d, cs, sn);
        x = x * cs + sg * xp * sn;
      }
      v[j] = x;
    }
    return v;
  }
};
struct EpiUkv {
  static constexpr bool STAGED = false;
  const P* p;
  __device__ __forceinline__ void operator()(int r, int c, f32x4 v) const {
    if (c < 256) {
#pragma unroll
      for (int j = 0; j < 4; ++j) p->knope[(long)(r + j) * 256 + c] = f2bf(v[j]);
    } else {
      long base; int key, Lk;
      if (r < NPROMPT) { base = (long)(r >> 8) * 65536; key = r & 255; Lk = 256; }
      else { int rr = r - NPROMPT; int b = rr / 4352; key = rr - b * 4352; Lk = 4352; base = 1048576L + (long)b * (256L * 4352L); }
      u32x2 o; o[0] = pack2(v[0], v[1]); o[1] = pack2(v[2], v[3]);
      *(u32x2*)(p->vtm + base + (long)(c - 256) * Lk + key) = o;
    }
  }
};

__device__ __forceinline__ void xcd_local_barrier(const P& p, const Sched& sc, unsigned* cnt) {
  asm volatile("s_waitcnt vmcnt(0)" ::: "memory");
  __syncthreads();
  if (threadIdx.x == 0) {
    xb_add(cnt, 1u);
    XB_SPIN(xb_ld(cnt) < (unsigned)sc.nloc, p.bar);
  }
  __syncthreads();
}
__device__ __forceinline__ void xcd_ln_then_sync(const P& p, const Sched& sc, int mode, const float* lg, const float* lb, int l,
                                                  int shift_idx, int scale_idx, unsigned* cnt) {
  const int base = sc.xcc * 12 * 16;
  for (int t = sc.rank; t < 192; t += sc.nloc) lnmod_rows(p, base + t, mode, lg, lb, l, shift_idx, scale_idx);
  asm volatile("s_waitcnt vmcnt(0)" ::: "memory");
  __syncthreads();
  if (threadIdx.x == 0) {
    xb_add(cnt, 1u);
    XB_SPIN(xb_ld(cnt) < (unsigned)sc.nloc, p.bar);
  }
  __syncthreads();
}

#define NPHASE 42
__device__ __forceinline__ void run_phase(const P& p, int ph, char* smem, const Sched& sc, int skip_ssd = 0) {
  const int bid = blockIdx.x, nb = gridDim.x;
  if (ph == 0) {
    for (int t = bid; t < 193 + 872; t += nb) {
      if (t < 193) pre_item(p, t, smem);
      else { const int q = t - 193; wconv_item(p, 0, q < WC_IN ? q : q + (WC_OUT + WC_FF1 + WC_FF2), smem); }
    }
    return;
  }
  if (ph == 41) {
    for (int t = bid; t < NTOK / 8; t += nb) lnmod_rows(p, t, 2, p.in[33] + 3 * DM, p.in[34] + 3 * DM, 3, 0, 0);
    return;
  }
  const int l = (ph - 1) / 10, s = (ph - 1) % 10;
  switch (s) {
    case 0: {
      for (int t = bid; t < NTOK / 8; t += nb) {
        if (l == 0) lnmod_rows(p, t, 0, nullptr, nullptr, l, 0, 1);
        else lnmod_rows(p, t, 1, p.in[33] + (l - 1) * DM, p.in[34] + (l - 1) * DM, l, 0, 1);
      }
    } break;
    case 1: {
      EpiProj e{p.proj, NPROJ};
      int mt, nt;
      if (sc.ok) {
        unsigned* cnt = p.bar + XCD_BAR_WORDS + 4096 + ((l * 2 + 0) * 8 + sc.xcc) * 64;
        if (l == 0) xcd_ln_then_sync(p, sc, 0, nullptr, nullptr, l, 0, 1, cnt);
        else xcd_ln_then_sync(p, sc, 1, p.in[33] + (l - 1) * DM, p.in[34] + (l - 1) * DM, l, 0, 1, cnt);
      }
      for (int it = 0; sched_tile(sc, 96, 26, 8, it, mt, nt); ++it) gemm_tile(p.hbf, LDH, p.winT, LDH, DM, mt * 128, nt * 128, smem, e);
      {
        int k = -1;
        if (sc.ok && sc.nloc == 64) { if (sc.rank >= 56 && sc.rank < 60) k = sc.xcc * 4 + (sc.rank - 56); }
        else if (bid < 2 * NT_PAST) k = bid;
        if (k >= 0) { if (k < NT_PAST) prep_diff(p, l, NT_OWN + k); else prep_mla(p, l, NT_OWN + k - NT_PAST); }
      }
    } break;
    case 2: {
      for (int t = bid; t < 4 * NT_OWN; t += nb) {
        if (t < NT_OWN) prep_dn(p, l, t);
        else if (t < 2 * NT_OWN) prep_ssd(p, l, t - NT_OWN);
        else if (t < 3 * NT_OWN) prep_diff(p, l, t - 2 * NT_OWN);
        else prep_mla(p, l, t - 3 * NT_OWN);
      }
    } break;
    case 3: {
      EpiUq eq{p.qm, 384, &p}; EpiUkv ek{&p};
      for (int t = bid; t < 1536 + 1536 + 288 + 400; t += nb) {
        if (t < 1536) dn_chunk_prep(p, t, smem);
        else if (t < 3072) ssd_chunk_prep(p, l, t - 1536, smem);
        else if (t < 3360) { int q = t - 3072; gemm_tile(p.cqn, LDQ, p.wuqT, LDQ, 256, (q / 3) * 128, (q % 3) * 128, smem, eq); }
        else { int q = t - 3360; gemm_tile(p.ckv, LDC, p.wukvT, LDC, 128, (q / 4) * 128, (q % 4) * 128, smem, ek); }
      }
    } break;
    case 4: {
      unsigned* cnt = p.bar + XCD_BAR_WORDS + 1024 + l * 64;
      for (;;) {
        __syncthreads();
        if (threadIdx.x == 0) sc.st[3] = xb_add(cnt, 1u);
        __syncthreads();
        const int it = (int)sc.st[3];
        const int nwc = (l == 0) ? (WC_OUT + WC_FF1) : 0;
        if (it >= P4_ITEMS + nwc) break;
        if (it < P4_ITEMS) p4_item(p, l, it, smem, skip_ssd);
        else wconv_item(p, l, WC_IN + (it - P4_ITEMS), smem);
      }
    } break;
    case 5: {
      if (sc.ok) { for (int t = sc.rank; t < 384; t += sc.nloc) finalize_rows(p, l, sc.xcc * 384 + t); }
      else for (int t = bid; t < NTOK / 4; t += nb) finalize_rows(p, l, t);
    } break;
    case 6: {
      EpiRes e{(bf16*)p.out + 1024, 2048, (const bf16*)p.out, p.mod, 2, l};
      int mt, nt;
      for (int it = 0; sched_tile(sc, 96, 8, 8, it, mt, nt); ++it) gemm_tile(p.hbf, LDH, p.woutT, LDH, DM, mt * 128, nt * 128, smem, e);
      {
        unsigned* cnt = p.bar + XCD_BAR_WORDS + 1024 + 512 + l * 64;
        for (;;) {
          __syncthreads();
          if (threadIdx.x == 0) sc.st[3] = xb_add(cnt, 1u);
          __syncthreads();
          const int q = (int)sc.st[3];
          if (q >= WC_FF2) break;
          wconv_item(p, l, WC_IN + WC_OUT + WC_FF1 + q, smem);
        }
      }
    } break;
    case 7: {
      for (int t = bid; t < NTOK / 8; t += nb) lnmod_rows(p, t, 1, p.in[31] + l * DM, p.in[32] + l * DM, l, 3, 4);
    } break;
    case 8: {
      EpiAct e{p.act, LDACT};
      int mt, nt;
      if (sc.ok) {
        unsigned* cnt = p.bar + XCD_BAR_WORDS + 4096 + ((l * 2 + 1) * 8 + sc.xcc) * 64;
        xcd_ln_then_sync(p, sc, 1, p.in[31] + l * DM, p.in[32] + l * DM, l, 3, 4, cnt);
      }
      for (int it = 0; sched_tile(sc, 96, 32, 8, it, mt, nt); ++it) gemm_tile(p.hbf, LDH, p.wff1T, LDH, DM, mt * 128, nt * 128, smem, e);
    } break;
    case 9: {
      EpiRes e{(bf16*)p.out + 1024, 2048, (const bf16*)p.out, p.mod, 5, l};
      int mt, nt;
      for (int it = 0; sched_tile(sc, 96, 8, 8, it, mt, nt); ++it) gemm_tile(p.act, LDACT, p.wff2T, LDACT, DFF, mt * 128, nt * 128, smem, e);
      if (l < 3) {
        unsigned* cnt = p.bar + XCD_BAR_WORDS + 1024 + 256 + l * 64;
        for (;;) {
          __syncthreads();
          if (threadIdx.x == 0) sc.st[3] = xb_add(cnt, 1u);
          __syncthreads();
          const int q = (int)sc.st[3];
          if (q >= 872 + WC_OUT + WC_FF1) break;
          if (q < 872) wconv_item(p, l + 1, q < WC_IN ? q : q + (WC_OUT + WC_FF1 + WC_FF2), smem);
          else wconv_item(p, l + 1, WC_IN + (q - 872), smem);
        }
      }
    } break;
  }
}

__global__ void __launch_bounds__(NTHR, 2) mega(P p, int ph_lo, int ph_hi, int coop) {
  __shared__ __attribute__((aligned(16))) char smem[SMEM_BYTES];
  __shared__ uint4 xb_words;
  if (threadIdx.x == 0) xb_words = make_uint4(0u, 0u, 0u, 0u);
  __syncthreads();
  XcdBarrier xb;
  xb.bar = p.bar; xb.x = 0; xb.st = (volatile LAS unsigned*)&xb_words;
  Sched sc; sc.xcc = 0; sc.rank = 0; sc.nloc = 1; sc.ok = 0; sc.st = (volatile LAS unsigned*)&xb_words;
  if (coop) {
    xb = xcd_barrier_post(p.bar, (volatile LAS unsigned*)&xb_words);
    if (threadIdx.x == 0) xb_words.z = xb_add(&p.bar[XCD_BAR_WORDS + 64 * xb.x], 1u);
    __syncthreads();
    sc.xcc = (int)xb.x; sc.rank = (int)((volatile LAS unsigned*)&xb_words)[2];
  }
  if (ph_hi > 1000) cg::this_grid().sync();
#define GRID_SYNC() xcd_barrier(xb)
  for (int ph = ph_lo; ph < ph_hi; ++ph) {
    if (coop && ph > ph_lo) {
      const unsigned nl = ((volatile LAS unsigned*)&xb_words)[0], nxx = ((volatile LAS unsigned*)&xb_words)[1];
      if (ph == ph_lo + 1) {
        unsigned hi = 0u;
#pragma unroll
        for (int j = 8; j < 16; ++j) hi |= xb_ld(&p.bar[XB_XCNT(j)]);
        sc.ok = (nxx == 8u && hi == 0u && nl > 0u) ? 1 : 0;
      }
      sc.nloc = (int)nl;
    }
    if (sc.ok && ph >= 1 && ph <= 40 && (((ph - 1) % 10) == 0 || ((ph - 1) % 10) == 7)) continue;
    run_phase(p, ph, smem, sc);
    if (coop && ph + 1 < ph_hi) {
      const int sph = (ph >= 1 && ph <= 40) ? (ph - 1) % 10 : -1;
      if (sc.ok && (sph == 5 || sph == 6)) xcd_local_barrier(p, sc, p.bar + XCD_BAR_WORDS + 8192 + ((((ph - 1) / 10) * 2 + (sph - 5)) * 8 + sc.xcc) * 64);
      else GRID_SYNC();
    }
#if (PROBE_MASK >> 10) & 1
    GRID_SYNC(); GRID_SYNC();
#endif
#if PROBE_MASK
    if (ph >= 1 && ph <= 40) {
      const int s = (ph - 1) % 10;
      if (((PROBE_MASK >> s) & 1) && s != 4) { run_phase(p, ph, smem, sc); GRID_SYNC(); }
    }
#endif
  }
}

static size_t align_up(size_t x) { return (x + 255) & ~(size_t)255; }

extern "C" void kernel_launch(void* const* d_in, const int* in_sizes, int n_in, void* d_out, int out_size, void* d_ws,
                              size_t ws_size, hipStream_t stream) {
  static int grid_blocks = 0;
  if (!grid_blocks) {
    int dev = 0, cus = 0, per_cu = 0;
    hipGetDevice(&dev);
    hipDeviceGetAttribute(&cus, hipDeviceAttributeMultiprocessorCount, dev);
    hipOccupancyMaxActiveBlocksPerMultiprocessor(&per_cu, mega, NTHR, 0);
    if (per_cu < 1) per_cu = 1;
    if (per_cu > 2) per_cu = 2;
    grid_blocks = cus * per_cu;
  }
  P p;
  memset(&p, 0, sizeof(p));
  for (int i = 0; i < 37; ++i) p.in[i] = (const float*)d_in[i];
  p.out = (float*)d_out;
  char* ws = (char*)d_ws;
  size_t off = 0;
  auto take = [&](size_t bytes) { char* q = ws + off; off = align_up(off + bytes); return q; };
  p.winT = (bf16*)take((size_t)NPROJ * LDH * 2);
  p.woutT = (bf16*)take((size_t)1024 * LDH * 2);
  p.wff1T = (bf16*)take((size_t)4096 * LDH * 2);
  p.wff2T = (bf16*)take((size_t)1024 * LDACT * 2);
  p.wuqT = (bf16*)take((size_t)384 * LDQ * 2);
  p.wukvT = (bf16*)take((size_t)512 * LDC * 2);
  p.mod = (float*)take((size_t)4 * 3 * 6144 * 4);
  p.ropeC = (float*)take(512 * 4);
  p.ropeS = (float*)take(512 * 4);
  p.hbf = (bf16*)take((size_t)NTOK * LDH * 2);
  size_t r1 = off;
  p.proj = (bf16*)take((size_t)NTOK * NPROJ * 2);
  p.qd = (bf16*)take((size_t)NTOK * 256 * 2);
  p.kd = (bf16*)take((size_t)NKROW * 256 * 2);
  p.vtd = (bf16*)take((size_t)3276800 * 2);
  p.cqn = (bf16*)take((size_t)NTOK * LDQ * 2);
  p.qm = (bf16*)take((size_t)NTOK * 384 * 2);
  p.ckv = (bf16*)take((size_t)NKROW * LDC * 2);
  p.kr = (bf16*)take((size_t)NKROW * 32 * 2);
  p.knope = (bf16*)take((size_t)NKROW * 256 * 2);
  p.vtm = (bf16*)take((size_t)3276800 * 2);
  size_t r2 = off;
  p.dq = (bf16*)take((size_t)NTOK * 256 * 2);
  p.dk = (bf16*)take((size_t)NTOK * 256 * 2);
  p.dv = (bf16*)take((size_t)NTOK * 256 * 2);
  p.dbeta = (float*)take((size_t)NTOK * 8 * 4);
  p.dg = (float*)take((size_t)NTOK * 8 * 4);
  p.sb = (bf16*)take((size_t)NTOK * 256 * 2);
  p.sc = (bf16*)take((size_t)NTOK * 256 * 2);
  if (off - r2 < (size_t)2 * NTOK * 256 * 4) off = r2 + (size_t)2 * NTOK * 256 * 4;
  p.ao = (bf16*)(ws + r2);
  p.sx = (bf16*)take((size_t)NTOK * 256 * 2);
  p.sdt = (float*)take((size_t)NTOK * 8 * 4);
  p.pu = (bf16*)take((size_t)1536 * 4096 * 2);
  p.pw = (bf16*)take((size_t)1536 * 4096 * 2);
  p.pqd = (bf16*)take((size_t)1536 * 4096 * 2);
  p.pqk = (bf16*)take((size_t)1536 * 4096 * 2);
  p.pkd = (bf16*)take((size_t)1536 * 4096 * 2);
  p.pgl = (float*)take(1536 * 4);
  p.pst = (bf16*)take((size_t)1536 * 8192 * 2);
  p.pcd = (bf16*)take((size_t)1536 * 8192 * 2);
  p.plast = (float*)take(1536 * 4);
  p.of = (bf16*)take((size_t)NTOK * 256 * 2);
  p.ob = (bf16*)take((size_t)NTOK * 256 * 2);
  p.yf = (float*)take((size_t)NTOK * 256 * 4);
  p.yb = (float*)take((size_t)NTOK * 256 * 4);
  p.bar = (unsigned*)take((size_t)(XCD_BAR_WORDS + 8192 + 4096) * 4);
  p.act = (bf16*)(ws + r1);
  size_t need = off;
  if (r1 + (size_t)NTOK * LDACT * 2 > need) need = r1 + (size_t)NTOK * LDACT * 2;
  if (need > ws_size) { fprintf(stderr, "kernel_launch: workspace too small: need %zu have %zu\n", need, ws_size); return; }
  hipMemsetAsync(p.bar, 0, (size_t)(XCD_BAR_WORDS + 8192 + 4096) * 4, stream);
#if MULTI_LAUNCH
  for (int ph = 0; ph < NPHASE; ++ph) {
    hipLaunchKernelGGL(mega, dim3(grid_blocks), dim3(NTHR), 0, stream, p, ph, ph + 1, 0);
  }
#else
  int lo = 0, hi = NPHASE, coop = 1;
  void* args[] = {&p, &lo, &hi, &coop};
  hipError_t e = hipLaunchCooperativeKernel((void*)mega, dim3(grid_blocks), dim3(NTHR), args, 0, stream);
  if (e != hipSuccess) fprintf(stderr, "cooperative launch failed: %s (grid %d)\n", hipGetErrorString(e), grid_blocks);
#endif
}
```
